# Optimizing an MI355X kernel written in HIP

```python
import math
import jax, jax.numpy as jnp
from jax import lax
import numpy as np

D_MODEL = 1024
BATCH = 16
SEQ = 2048
DEPTH = 4

GRID_W = 64
CTX_LEN = 256
HEAD_DIM = 64
A_Q_HEADS = 16
A_KV_HEADS = 4
A_GROUP = A_Q_HEADS // A_KV_HEADS
WINDOW = 128
BLOCK = 128
B_HEADS = D_MODEL // (2 * HEAD_DIM)
N_EXPERTS = 16
N_GROUPS = 4
GROUP_SIZE = N_EXPERTS // N_GROUPS
TOP_K = 2
GROUP_SCORE_K = 2
D_EXPERT = D_MODEL // 2
ROPE_THETA = 10000.0
N_A_LAYERS = (DEPTH + 1) // 2
N_B_LAYERS = DEPTH // 2
DEEPNORM_ALPHA = (2 * DEPTH) ** 0.25
DEEPNORM_BETA = (8 * DEPTH) ** -0.25
LN_EPS = 1e-6
SUBLN_EPS = 1e-5
NEG_INF = -1e30
ATTN_SCALE = HEAD_DIM ** -0.5

kernel_name = "hybrid_swa_diffattn_sharedrouter_moe_dit"

F32 = jnp.float32


def layer_norm(x, g, b):
    xf = x.astype(F32)
    mu = xf.mean(-1, keepdims=True)
    var = jnp.square(xf - mu).mean(-1, keepdims=True)
    return ((xf - mu) * lax.rsqrt(var + LN_EPS) * g.astype(F32) + b.astype(F32)).astype(x.dtype)


def rms_norm(x, g):
    xf = x.astype(F32)
    return (xf * lax.rsqrt(jnp.square(xf).mean(-1, keepdims=True) + SUBLN_EPS) * g.astype(F32)).astype(x.dtype)


def axial_rope_tables(n_tokens):
    n_rows = n_tokens // GRID_W
    rows = jnp.broadcast_to(jnp.arange(n_rows)[:, None], (n_rows, GRID_W)).reshape(-1)
    cols = jnp.broadcast_to(jnp.arange(GRID_W)[None, :], (n_rows, GRID_W)).reshape(-1)
    quarter = HEAD_DIM // 4
    inv_freq = ROPE_THETA ** (-jnp.arange(quarter, dtype=F32) / quarter)
    ang_r = rows.astype(F32)[:, None] * inv_freq
    ang_c = cols.astype(F32)[:, None] * inv_freq
    return (jnp.cos(ang_r), jnp.sin(ang_r), jnp.cos(ang_c), jnp.sin(ang_c))


def _rotate(x, cos, sin):
    x1, x2 = jnp.split(x, 2, axis=-1)
    return jnp.concatenate([x1 * cos - x2 * sin, x2 * cos + x1 * sin], axis=-1)


def apply_axial_rope(x, tables):
    cos_r, sin_r, cos_c, sin_c = tables
    shape = (x.shape[1],) + (1,) * (x.ndim - 3) + (cos_r.shape[-1],)
    xr, xc = jnp.split(x.astype(F32), 2, axis=-1)
    out = jnp.concatenate([_rotate(xr, cos_r.reshape(shape), sin_r.reshape(shape)),
                           _rotate(xc, cos_c.reshape(shape), sin_c.reshape(shape))], axis=-1)
    return out.astype(x.dtype)


def sink_attend(q, parts, sink):
    scores = []
    for k, v, mask in parts:
        s = jnp.einsum('bqhgd,bkhd->bhgqk', q, k).astype(F32) * ATTN_SCALE
        if mask is not None:
            s = jnp.where(mask, s, NEG_INF)
        scores.append(s)
    snk = sink.astype(F32)[None, :, :, None, None]
    m = snk
    for s in scores:
        m = jnp.maximum(m, s.max(-1, keepdims=True))
    probs = [jnp.exp(s - m) for s in scores]
    denom = jnp.exp(snk - m)
    for p in probs:
        denom = denom + p.sum(-1, keepdims=True)
    out = None
    for p, (k, v, mask) in zip(probs, parts):
        o = jnp.einsum('bhgqk,bkhd->bqhgd', (p / denom).astype(v.dtype), v)
        out = o if out is None else out + o
    return out


def window_attention_latent(q, k, v, kc, vc, sink):
    S = q.shape[1]
    nb = S // BLOCK
    span = BLOCK + 2 * WINDOW
    kp = jnp.pad(k, ((0, 0), (WINDOW, WINDOW), (0, 0), (0, 0)))
    vp = jnp.pad(v, ((0, 0), (WINDOW, WINDOW), (0, 0), (0, 0)))
    r = jnp.arange(span)
    qi = jnp.arange(BLOCK)
    band = jnp.abs((r - WINDOW)[None, :] - qi[:, None]) <= WINDOW

    def block(n):
        start = n * BLOCK
        qb = lax.dynamic_slice_in_dim(q, start, BLOCK, axis=1)
        kb = lax.dynamic_slice_in_dim(kp, start, span, axis=1)
        vb = lax.dynamic_slice_in_dim(vp, start, span, axis=1)
        key_pos = start - WINDOW + r
        mask = band & ((key_pos >= 0) & (key_pos < S))[None, :]
        return sink_attend(qb, [(kb, vb, mask), (kc, vc, None)], sink)

    out = lax.map(block, jnp.arange(nb))
    return jnp.moveaxis(out, 0, 1).reshape(q.shape)


def window_gqa_mixer(hl, hc, w_qkv, w_o, sink, tables, with_ctx_out):
    B, S, _ = hl.shape
    C = hc.shape[1]
    q_dim = A_Q_HEADS * HEAD_DIM
    kv_dim = A_KV_HEADS * HEAD_DIM
    ql, kl, vl = jnp.split(hl @ w_qkv, [q_dim, q_dim + kv_dim], axis=-1)
    ql = apply_axial_rope(ql.reshape(B, S, A_KV_HEADS, A_GROUP, HEAD_DIM), tables)
    kl = apply_axial_rope(kl.reshape(B, S, A_KV_HEADS, HEAD_DIM), tables)
    vl = vl.reshape(B, S, A_KV_HEADS, HEAD_DIM)
    kc, vc = jnp.split(hc @ w_qkv[:, q_dim:], 2, axis=-1)
    kc = kc.reshape(B, C, A_KV_HEADS, HEAD_DIM)
    vc = vc.reshape(B, C, A_KV_HEADS, HEAD_DIM)
    sink_hg = sink.reshape(A_KV_HEADS, A_GROUP)
    out_l = window_attention_latent(ql, kl, vl, kc, vc, sink_hg).reshape(B, S, q_dim) @ w_o
    if not with_ctx_out:
        return out_l, None
    qc = (hc @ w_qkv[:, :q_dim]).reshape(B, C, A_KV_HEADS, A_GROUP, HEAD_DIM)
    out_c = sink_attend(qc, [(kc, vc, None)], sink_hg).reshape(B, C, q_dim) @ w_o
    return out_l, out_c


def diff_attend(q, k, v, lam):
    s = jnp.einsum('bqhmd,bkhmd->bhmqk', q, k).astype(F32) * ATTN_SCALE
    p = jax.nn.softmax(s, axis=-1)
    a = p[:, :, 0] - lam * p[:, :, 1]
    return jnp.einsum('bhqk,bkhe->bqhe', a.astype(v.dtype), v)


def diff_mixer(hl, hc, w_qkv, w_o, lam_params, subln_g, lam_init, tables, with_ctx_out):
    B, S, _ = hl.shape
    C = hc.shape[1]
    dq = B_HEADS * 2 * HEAD_DIM
    ql, kl, vl = jnp.split(hl @ w_qkv, [dq, 2 * dq], axis=-1)
    ql = apply_axial_rope(ql.reshape(B, S, B_HEADS, 2, HEAD_DIM), tables)
    kl = apply_axial_rope(kl.reshape(B, S, B_HEADS, 2, HEAD_DIM), tables)
    vl = vl.reshape(B, S, B_HEADS, 2 * HEAD_DIM)
    kc, vc = jnp.split(hc @ w_qkv[:, dq:], 2, axis=-1)
    kc = kc.reshape(B, C, B_HEADS, 2, HEAD_DIM)
    vc = vc.reshape(B, C, B_HEADS, 2 * HEAD_DIM)
    lp = lam_params.astype(F32)
    lam = jnp.exp(jnp.sum(lp[0] * lp[1])) - jnp.exp(jnp.sum(lp[2] * lp[3])) + lam_init
    k_all = jnp.concatenate([kl, kc], axis=1)
    v_all = jnp.concatenate([vl, vc], axis=1)

    def block(n):
        qb = lax.dynamic_slice_in_dim(ql, n * BLOCK, BLOCK, axis=1)
        return diff_attend(qb, k_all, v_all, lam)

    out_l = jnp.moveaxis(lax.map(block, jnp.arange(S // BLOCK)), 0, 1).reshape(B, S, B_HEADS, 2 * HEAD_DIM)

    def finish(o):
        n = o.shape[1]
        return (rms_norm(o, subln_g) * (1.0 - lam_init)).reshape(B, n, dq) @ w_o

    if not with_ctx_out:
        return finish(out_l), None
    qc = (hc @ w_qkv[:, :dq]).reshape(B, C, B_HEADS, 2, HEAD_DIM)
    out_c = diff_attend(qc, kc, vc, lam)
    return finish(out_l), finish(out_c)


def moe_ffn(h, w_router, router_bias, w_gate, w_up, w_down):
    N = h.shape[0]
    s = jax.nn.sigmoid(h.astype(F32) @ w_router.astype(F32))
    biased = s + router_bias.astype(F32)
    bg = biased.reshape(N, N_GROUPS, GROUP_SIZE)
    gscore = lax.top_k(bg, GROUP_SCORE_K)[0].sum(-1)
    gsel = jnp.argmax(gscore, axis=-1)
    in_group = jnp.take_along_axis(bg, gsel[:, None, None], axis=1)[:, 0]
    _, loc = lax.top_k(in_group, TOP_K)
    eid = gsel[:, None] * GROUP_SIZE + loc
    s_sel = jnp.take_along_axis(s, eid, axis=-1)
    w = s_sel / s_sel.sum(-1, keepdims=True)
    gates = (jax.nn.one_hot(eid, N_EXPERTS, dtype=F32) * w[..., None]).sum(1)
    out = jnp.zeros_like(h)
    for e in range(N_EXPERTS):
        y = (jax.nn.silu(h @ w_gate[e]) * (h @ w_up[e])) @ w_down[e]
        out = out + gates[:, e:e + 1].astype(h.dtype) * y
    return out


def setup_inputs(seed: int = 0) -> dict:
    key = jax.random.key(seed)
    ks = jax.random.split(key, 22)

    def nrm(k, shape, scale):
        return jax.random.normal(k, shape, F32) * scale

    D = D_MODEL
    qa = A_Q_HEADS * HEAD_DIM
    kva = A_KV_HEADS * HEAD_DIM
    dq = B_HEADS * 2 * HEAD_DIM
    return {
        "x": nrm(ks[0], (BATCH, SEQ, D), 1.0),
        "c": nrm(ks[1], (BATCH, D), 1.0),
        "ctx": nrm(ks[2], (BATCH, CTX_LEN, D), 1.0),
        "c_ctx": nrm(ks[3], (D,), 1.0),
        "w_ada": nrm(ks[4], (DEPTH, D, 6 * D), 0.5 * D ** -0.5),
        "b_ada": nrm(ks[5], (DEPTH, 6 * D), 0.02),
        "wqkv_a": nrm(ks[6], (N_A_LAYERS, D, qa + 2 * kva), D ** -0.5),
        "wo_a": nrm(ks[7], (N_A_LAYERS, qa, D), qa ** -0.5 * DEEPNORM_BETA),
        "sink_a": nrm(ks[8], (N_A_LAYERS, A_Q_HEADS), 0.5),
        "wqkv_b": nrm(ks[9], (N_B_LAYERS, D, 3 * dq), D ** -0.5),
        "wo_b": nrm(ks[10], (N_B_LAYERS, dq, D), dq ** -0.5 * DEEPNORM_BETA),
        "lambda_b": nrm(ks[11], (N_B_LAYERS, 4, HEAD_DIM), 0.1),
        "subln_b": 1.0 + nrm(ks[12], (N_B_LAYERS, 2 * HEAD_DIM), 0.02),
        "ln_attn_g": 1.0 + nrm(ks[13], (DEPTH, D), 0.02),
        "ln_attn_b": nrm(ks[14], (DEPTH, D), 0.02),
        "ln_ffn_g": 1.0 + nrm(ks[15], (DEPTH, D), 0.02),
        "ln_ffn_b": nrm(ks[16], (DEPTH, D), 0.02),
        "w_router": nrm(ks[17], (D, N_EXPERTS), D ** -0.5),
        "router_bias": nrm(ks[18], (N_EXPERTS,), 0.01),
        "w_gate": nrm(ks[19], (DEPTH, N_EXPERTS, D, D_EXPERT), D ** -0.5),
        "w_up": nrm(ks[20], (DEPTH, N_EXPERTS, D, D_EXPERT), D ** -0.5),
        "w_down": nrm(ks[21], (DEPTH, N_EXPERTS, D_EXPERT, D), D_EXPERT ** -0.5 * DEEPNORM_BETA),
    }


def reference(x, c, ctx, c_ctx, w_ada, b_ada, wqkv_a, wo_a, sink_a, wqkv_b, wo_b, lambda_b, subln_b,
              ln_attn_g, ln_attn_b, ln_ffn_g, ln_ffn_b, w_router, router_bias, w_gate, w_up, w_down):
    B, S, D = x.shape
    C = ctx.shape[1]
    tables = axial_rope_tables(S)
    xl, xc = x, ctx
    silu_c = jax.nn.silu(c)
    silu_cc = jax.nn.silu(c_ctx)
    for i in range(DEPTH):
        last = i == DEPTH - 1
        mod_l = (silu_c @ w_ada[i] + b_ada[i])[:, None, :]
        mod_c = silu_cc @ w_ada[i] + b_ada[i]
        sh1_l, sc1_l, g1_l, sh2_l, sc2_l, g2_l = jnp.split(mod_l, 6, axis=-1)
        sh1_c, sc1_c, g1_c, sh2_c, sc2_c, g2_c = jnp.split(mod_c, 6, axis=-1)

        hl = xl * (1.0 + sc1_l) + sh1_l
        hc = xc * (1.0 + sc1_c) + sh1_c
        j = i // 2
        if i % 2 == 0:
            al, ac = window_gqa_mixer(hl, hc, wqkv_a[j], wo_a[j], sink_a[j], tables, not last)
        else:
            lam_init = 0.8 - 0.6 * math.exp(-0.3 * i)
            al, ac = diff_mixer(hl, hc, wqkv_b[j], wo_b[j], lambda_b[j], subln_b[j], lam_init, tables, not last)
        xl = layer_norm(DEEPNORM_ALPHA * xl + g1_l * al, ln_attn_g[i], ln_attn_b[i])

        hl2 = (xl * (1.0 + sc2_l) + sh2_l).reshape(B * S, D)
        if last:
            yl = moe_ffn(hl2, w_router, router_bias, w_gate[i], w_up[i], w_down[i]).reshape(B, S, D)
        else:
            xc = layer_norm(DEEPNORM_ALPHA * xc + g1_c * ac, ln_attn_g[i], ln_attn_b[i])
            hc2 = (xc * (1.0 + sc2_c) + sh2_c).reshape(B * C, D)
            y = moe_ffn(jnp.concatenate([hl2, hc2], axis=0), w_router, router_bias, w_gate[i], w_up[i], w_down[i])
            yl = y[:B * S].reshape(B, S, D)
            yc = y[B * S:].reshape(B, C, D)
            xc = layer_norm(DEEPNORM_ALPHA * xc + g2_c * yc, ln_ffn_g[i], ln_ffn_b[i])
        xl = layer_norm(DEEPNORM_ALPHA * xl + g2_l * yl, ln_ffn_g[i], ln_ffn_b[i])
    return xl
```

```cpp
#include <hip/hip_runtime.h>
#include <cstdio>
#include <cstdint>

namespace pg8 {
#define PG8_LAS __attribute__((address_space(3)))
typedef unsigned short bf16_t;
typedef short bf16x8 __attribute__((ext_vector_type(8)));
typedef float f32x4 __attribute__((ext_vector_type(4)));
typedef unsigned u32x4 __attribute__((ext_vector_type(4)));
typedef unsigned u32x2 __attribute__((ext_vector_type(2)));
constexpr int BM = 256, BK = 64, HALF = 128, HTB = HALF * BK * 2  , STAGE_BYTES = 8 * HTB, NXCD = 8, WGM = 8;

__host__ __device__ __forceinline__ int lds_byte(int r, int c) { const int st = (r >> 4) * 2 + (c >> 5), rr = r & 15, cc = c & 31, ob = rr * 64 + cc * 2; return st * 1024 + (ob ^ (((ob >> 9) & 1) << 5)); }
__host__ __device__ __forceinline__ void stage_rc(int b, int& R, int& C) { const int st = b / 1024, sb = b % 1024, swz = sb ^ (((sb >> 9) & 1) << 5); R = (st >> 1) * 16 + swz / 64; C = (st & 1) * 32 + (swz % 64) / 2; }
__host__ __device__ __forceinline__ int perm32(int rho) { const int n = rho >> 4, i = rho & 15; return 8 * (i >> 2) + 4 * n + (i & 3); }

struct Unit { int pm, pn, pb; };
struct Gemm { const bf16_t* A; const bf16_t* Bt; int M, N, K; const int* rowlist; PG8_LAS int* rowtab; };

struct StaticOrder {
    int nM, nN, nwg, G, c;
    __host__ __device__ void init(int M, int N, int G_, int c_) { nM = M / BM; nN = N / BM; nwg = nM * nN; G = G_; c = c_; }
    __host__ __device__ bool next(int i, Unit& u) const {
        const long L = (long)i * G + c; if (L >= nwg) return false;
        int wgid = (int)L; { const int q = nwg / NXCD, r = nwg % NXCD, xcd = wgid % NXCD, off = wgid / NXCD; wgid = (xcd < r ? xcd * (q + 1) : r * (q + 1) + (xcd - r) * q) + off; }
        const int nig = WGM * nN, gid = wgid / nig, fm = gid * WGM, gsz = (nM - fm) < WGM ? (nM - fm) : WGM;
        u.pm = fm + ((wgid % nig) % gsz); u.pn = (wgid % nig) / gsz; u.pb = u.pn; return true;
    }
    __device__ __forceinline__ void a_ready(const Unit&) const {}
    __device__ __forceinline__ void done(const Unit&) const {}
};
struct GroupedOrder {
    const PG8_LAS int* tb; int nwg, G, c;
    __device__ __forceinline__ void init(const PG8_LAS int* tb_, int G_, int c_) { tb = tb_; nwg = tb_[16] * 4; G = G_; c = c_; }
    __device__ __forceinline__ bool next(int i, Unit& u) const {
        const long L = (long)i * G + c; if (L >= nwg) return false;
        int wgid = (int)L; { const int q = nwg / NXCD, r = nwg % NXCD, xcd = wgid % NXCD, off = wgid / NXCD; wgid = (xcd < r ? xcd * (q + 1) : r * (q + 1) + (xcd - r) * q) + off; }
        u.pm = wgid >> 2; u.pn = wgid & 3; int e = 0;
#pragma unroll
        for (int j = 1; j < 16; ++j) e += (tb[j] <= u.pm) ? 1 : 0;
        u.pb = e * 4 + u.pn; return true;
    }
    __device__ __forceinline__ void a_ready(const Unit&) const {}
    __device__ __forceinline__ void done(const Unit&) const {}
};

__device__ __forceinline__ unsigned cvt_pk_bf16(float lo, float hi) { unsigned r; asm volatile("v_cvt_pk_bf16_f32 %0, %1, %2" : "=v"(r) : "v"(lo), "v"(hi)); return r; }

struct EpiStore {
    static constexpr bool PERM = true, AFTER_DRAIN = false;
    bf16_t* O; int ldc;
    __device__ __forceinline__ void operator()(const f32x4 (&acc)[2][2][4][2], const Unit& u, int wr, int wc, int fr, int fq) const {
        const int row0 = u.pm * BM + wr * 64 + fr, col0 = u.pn * BM + wc * 32 + 8 * fq;
#pragma unroll
        for (int ai = 0; ai < 2; ++ai)
#pragma unroll
            for (int m = 0; m < 4; ++m) { bf16_t* rowp = O + (size_t)(row0 + ai * HALF + m * 16) * ldc + col0;
#pragma unroll
                for (int bj = 0; bj < 2; ++bj) { const f32x4 v0 = acc[ai][bj][m][0], v1 = acc[ai][bj][m][1];
                    u32x4 w; w.x = cvt_pk_bf16(v0[0], v0[1]); w.y = cvt_pk_bf16(v0[2], v0[3]); w.z = cvt_pk_bf16(v1[0], v1[1]); w.w = cvt_pk_bf16(v1[2], v1[3]);
                    *(u32x4*)(rowp + bj * HALF) = w; } }
    }
};
struct EpiGateUp {
    static constexpr bool PERM = true, AFTER_DRAIN = false;
    bf16_t* O;
    __device__ __forceinline__ void operator()(const f32x4 (&acc)[2][2][4][2], const Unit& u, int wr, int wc, int fr, int fq) const {
        const int row0 = u.pm * BM + wr * 64 + fr, col0 = (u.pn * BM + wc * 32 + 8 * fq) >> 1;
#pragma unroll
        for (int ai = 0; ai < 2; ++ai)
#pragma unroll
            for (int m = 0; m < 4; ++m) { bf16_t* rowp = O + (size_t)(row0 + ai * HALF + m * 16) * 512 + col0;
#pragma unroll
                for (int bj = 0; bj < 2; ++bj) { const f32x4 g = acc[ai][bj][m][0], up = acc[ai][bj][m][1]; f32x4 a;
#pragma unroll
                    for (int e = 0; e < 4; ++e) { const float sg = __builtin_amdgcn_rcpf(1.0f + __builtin_amdgcn_exp2f(-1.4426950408889634f * g[e])); a[e] = g[e] * sg * up[e]; }
                    u32x2 w; w.x = cvt_pk_bf16(a[0], a[1]); w.y = cvt_pk_bf16(a[2], a[3]);
                    *(u32x2*)(rowp + bj * (HALF / 2)) = w; } }
    }
};
struct EpiQKV {
    static constexpr bool PERM = true, AFTER_DRAIN = false;
    bf16_t *Q, *K, *V; int kvp, nk; const float* rope; float qscale;
    __device__ __forceinline__ void operator()(const f32x4 (&acc)[2][2][4][2], const Unit& u, int wr, int wc, int fr, int fq) const {
        bf16_t* base; int ldc, colt; bool rp; float sc;
        if (u.pn < 4) { base = Q; ldc = 1024; colt = u.pn * BM; rp = true; sc = qscale; }
        else if (u.pn < 4 + nk) { base = K; ldc = kvp; colt = (u.pn - 4) * BM; rp = true; sc = 1.0f; }
        else { base = V; ldc = kvp; colt = (u.pn - 4 - nk) * BM; rp = false; sc = 1.0f; }
        rp = rp && (u.pm < 128);
        const int row0 = u.pm * BM + wr * 64 + fr, col0 = colt + wc * 32 + 8 * fq;
        const int pi0 = (col0 & 63) >> 1; const bool rowax = (wc & 1) == 0;
        f32x4 t0[4], t1[4];
#pragma unroll
        for (int i = 0; i < 4; ++i) { t0[i] = (f32x4){1.f, 0.f, 1.f, 0.f}; t1[i] = t0[i]; }
        if (rp) {
            if (rowax) {
#pragma unroll
                for (int ai = 0; ai < 2; ++ai) { const int pos = ((u.pm * BM + ai * HALF + wr * 64) & 2047) & ~63; const float* tp = rope + ((size_t)pos * 32 + pi0) * 2; t0[ai] = *(const f32x4*)tp; t1[ai] = *(const f32x4*)(tp + 4); }
            } else {
#pragma unroll
                for (int m = 0; m < 4; ++m) { const int pos = m * 16 + fr; const float* tp = rope + ((size_t)pos * 32 + pi0) * 2; t0[m] = *(const f32x4*)tp; t1[m] = *(const f32x4*)(tp + 4); }
            }
        }
#pragma unroll
        for (int ai = 0; ai < 2; ++ai)
#pragma unroll
            for (int m = 0; m < 4; ++m) { const int row = row0 + ai * HALF + m * 16; bf16_t* rowp = base + (size_t)row * ldc + col0;
                const f32x4 c0 = rowax ? t0[ai] : t0[m], c1 = rowax ? t1[ai] : t1[m];
#pragma unroll
                for (int bj = 0; bj < 2; ++bj) { f32x4 v0 = acc[ai][bj][m][0], v1 = acc[ai][bj][m][1];
                    if (rp) { f32x4 a, b;
                        a[0] = v0[0] * c0[0] - v0[1] * c0[1]; a[1] = v0[1] * c0[0] + v0[0] * c0[1]; a[2] = v0[2] * c0[2] - v0[3] * c0[3]; a[3] = v0[3] * c0[2] + v0[2] * c0[3];
                        b[0] = v1[0] * c1[0] - v1[1] * c1[1]; b[1] = v1[1] * c1[0] + v1[0] * c1[1]; b[2] = v1[2] * c1[2] - v1[3] * c1[3]; b[3] = v1[3] * c1[2] + v1[2] * c1[3];
                        v0 = a; v1 = b; }
                    v0 = v0 * sc; v1 = v1 * sc;
                    u32x4 w; w.x = cvt_pk_bf16(v0[0], v0[1]); w.y = cvt_pk_bf16(v0[2], v0[3]); w.z = cvt_pk_bf16(v1[0], v1[1]); w.w = cvt_pk_bf16(v1[2], v1[3]);
                    *(u32x4*)(rowp + bj * HALF) = w; } }
    }
};

template <class Epi, class Sched, bool ALIGN_EPI = false, bool SP2 = false, bool GATHER = false>
__device__ __forceinline__ void gemm_phase(PG8_LAS unsigned char* lds, const Gemm g, const Sched& S, const Epi& E) {
    int tid_ = threadIdx.x; asm volatile("" : "+v"(tid_));
    const int tid = tid_, wid = __builtin_amdgcn_readfirstlane(tid >> 6), lane = tid & 63, wr = wid >> 2, wc = wid & 3, fr = lane & 15, fq = lane >> 4;
    const int K = g.K, nt = K / BK;
    unsigned voffA[2], voffB[2];
#pragma unroll
    for (int i = 0; i < 2; ++i) { int R, C; stage_rc(tid * 16 + i * 8192, R, C); const int Rb = Epi::PERM ? ((R & ~31) + perm32(R & 31)) : R;
        voffA[i] = (unsigned)(R * K + C) * 2u; voffB[i] = (unsigned)(Rb * K + C) * 2u; }
    unsigned vc[2] = {0u, 0u}, vn[2] = {0u, 0u}, cofs[2] = {0u, 0u}; const size_t rowb = (size_t)K * 2;
    if constexpr (GATHER) {
#pragma unroll
        for (int i = 0; i < 2; ++i) { int R, C; stage_rc(tid * 16 + i * 8192, R, C); cofs[i] = (unsigned)C * 2u; }
        Unit u_;
        for (int i = 0; S.next(i, u_); ++i) if (tid < 256) g.rowtab[i * 256 + tid] = g.rowlist[u_.pm * 256 + tid];
        asm volatile("s_waitcnt vmcnt(0) lgkmcnt(0)" ::: "memory"); __builtin_amdgcn_s_barrier(); asm volatile("" ::: "memory");
    }
#define PG8_LDROWS(slot, dst) do { int R0_, C0_, R1_, C1_; stage_rc(tid * 16, R0_, C0_); stage_rc(tid * 16 + 8192, R1_, C1_); \
        _Pragma("unroll") for (int h_ = 0; h_ < 2; ++h_) dst[h_] = (unsigned)g.rowtab[(slot) * 256 + h_ * 128 + R0_] | ((unsigned)g.rowtab[(slot) * 256 + h_ * 128 + R1_] << 16); } while (0)
    const size_t kstep = (size_t)(BK * 2);
    const size_t hstep = (size_t)HALF * K * 2;
    const size_t tstep = 2 * hstep;
    const unsigned ldsw = (unsigned)wid * 1024u;
    const int aoff = lds_byte(wr * 64 + fr, fq * 8), boff = lds_byte(wc * 32 + fr, fq * 8);
#define PG8_SA(b, h) (((b) * 2 + (h)) * HTB)
#define PG8_SB(b, h) ((4 + (b) * 2 + (h)) * HTB)
#define PG8_STAGE(bufoff, gbase, voff) do { _Pragma("unroll") for (int _i = 0; _i < 2; ++_i) \
        __builtin_amdgcn_global_load_lds((const unsigned*)((const char*)(gbase) + (voff)[_i]), (PG8_LAS unsigned*)(lds + (bufoff) + ldsw + _i * 8192), 16, 0, 0); } while (0)
#define PG8_STAGE_A(bufoff, abase, h, NX) do { if constexpr (GATHER) { const unsigned rp_ = (NX) ? vn[h] : vc[h]; \
        _Pragma("unroll") for (int _i = 0; _i < 2; ++_i) { const unsigned row_ = _i ? (rp_ >> 16) : (rp_ & 0xffffu); \
            __builtin_amdgcn_global_load_lds((const unsigned*)((const char*)(abase) + (size_t)row_ * rowb + cofs[_i]), (PG8_LAS unsigned*)(lds + (bufoff) + ldsw + _i * 8192), 16, 0, 0); } } \
    else { PG8_STAGE(bufoff, (abase) + ((h) ? hstep : (size_t)0), voffA); } } while (0)
#define PG8_LDA(dst, b, h) do { _Pragma("unroll") for (int m = 0; m < 4; ++m) _Pragma("unroll") for (int k = 0; k < 2; ++k) dst[m][k] = *(const PG8_LAS bf16x8*)(lds + PG8_SA(b, h) + aoff + m * 2048 + k * 1024); } while (0)
#define PG8_LDB(dst, b, h) do { _Pragma("unroll") for (int n = 0; n < 2; ++n) _Pragma("unroll") for (int k = 0; k < 2; ++k) dst[n][k] = *(const PG8_LAS bf16x8*)(lds + PG8_SB(b, h) + boff + n * 2048 + k * 1024); } while (0)
#define PG8_MMA(ai, bj, At, Bt) do { __builtin_amdgcn_s_setprio(1); _Pragma("unroll") for (int m = 0; m < 4; ++m) _Pragma("unroll") for (int n = 0; n < 2; ++n) _Pragma("unroll") for (int k = 0; k < 2; ++k) \
        acc[ai][bj][m][n] = __builtin_amdgcn_mfma_f32_16x16x32_bf16(Bt[n][k], At[m][k], acc[ai][bj][m][n], 0, 0, 0); __builtin_amdgcn_s_setprio(0); } while (0)
#define PG8_WAIT_V(n) asm volatile("s_waitcnt vmcnt(" #n ")" ::: "memory")
#define PG8_WAIT_L(n) asm volatile("s_waitcnt lgkmcnt(" #n ")" ::: "memory")
#define PG8_BAR __builtin_amdgcn_s_barrier()
#define PG8_SCHED __builtin_amdgcn_sched_barrier(0)
    Unit cur, nxt; int ui = 0;
    if (!S.next(0, cur)) return;
    f32x4 acc[2][2][4][2];
#pragma unroll
    for (int a = 0; a < 2; ++a)
#pragma unroll
        for (int b = 0; b < 2; ++b)
#pragma unroll
            for (int m = 0; m < 4; ++m)
#pragma unroll
                for (int n = 0; n < 2; ++n) acc[a][b][m][n] = (f32x4){0.f, 0.f, 0.f, 0.f};
    bf16x8 At[4][2], B0[2][2], B1[2][2];
    const char* cA = (const char*)g.A + (GATHER ? (size_t)0 : (size_t)cur.pm * tstep); const char* cB = (const char*)g.Bt + (size_t)cur.pb * tstep;
    if constexpr (GATHER) { PG8_LDROWS(0, vc); }
    S.a_ready(cur);
    if constexpr (SP2) {
        PG8_STAGE(PG8_SB(0, 0), cB, voffB); PG8_STAGE(PG8_SB(0, 1), cB + hstep, voffB); PG8_STAGE_A(PG8_SA(0, 0), cA, 0, false); PG8_STAGE_A(PG8_SA(0, 1), cA, 1, false);
        if (wr == 1) PG8_BAR;
        PG8_WAIT_V(2); PG8_BAR;
        PG8_STAGE(PG8_SB(1, 0), cB + kstep, voffB); PG8_STAGE_A(PG8_SA(1, 0), cA + kstep, 0, false); PG8_STAGE(PG8_SB(1, 1), cB + hstep + kstep, voffB);
        PG8_WAIT_V(6); PG8_BAR;
    } else {
        PG8_STAGE(PG8_SB(0, 0), cB, voffB); PG8_STAGE_A(PG8_SA(0, 0), cA, 0, false); PG8_STAGE(PG8_SB(0, 1), cB + hstep, voffB); PG8_STAGE_A(PG8_SA(0, 1), cA, 1, false);
        if (wr == 1) PG8_BAR;
        PG8_WAIT_V(4); PG8_BAR;
        PG8_STAGE(PG8_SB(1, 0), cB + kstep, voffB); PG8_STAGE_A(PG8_SA(1, 0), cA + kstep, 0, false); PG8_STAGE(PG8_SB(1, 1), cB + hstep + kstep, voffB);
        PG8_WAIT_V(6); PG8_BAR;
    }
    for (;;) {
        const bool has_next = S.next(ui + 1, nxt);
        const char* nA = (has_next && !GATHER) ? (const char*)g.A + (size_t)nxt.pm * tstep : cA;
        if constexpr (GATHER) { if (has_next) { PG8_LDROWS(ui + 1, vn); } else { vn[0] = vc[0]; vn[1] = vc[1]; } } const char* nB = has_next ? (const char*)g.Bt + (size_t)nxt.pb * tstep : cB;
        for (int t = 0; t < nt; t += 2) {
            const bool last = (t == nt - 2);
            const char* a1 = cA + (size_t)(t + 1) * kstep;
            const char* a2 = last ? nA : cA + (size_t)(t + 2) * kstep; const char* b2 = last ? nB : cB + (size_t)(t + 2) * kstep;
            const char* a3 = a2 + kstep; const char* b3 = b2 + kstep;
            if (last && has_next) S.a_ready(nxt);
            if constexpr (SP2) {
            PG8_LDB(B0, 0, 0); PG8_LDB(B1, 0, 1); PG8_SCHED; PG8_LDA(At, 0, 0); PG8_STAGE_A(PG8_SA(1, 1), a1, 1, false);
            PG8_WAIT_V(8); PG8_WAIT_L(0); PG8_BAR; PG8_MMA(0, 0, At, B0); PG8_MMA(0, 1, At, B1); PG8_BAR; PG8_SCHED;
            PG8_LDA(At, 0, 1); PG8_STAGE(PG8_SB(0, 0), b2, voffB); PG8_STAGE(PG8_SB(0, 1), b2 + hstep, voffB); PG8_STAGE_A(PG8_SA(0, 0), a2, 0, last);
            PG8_WAIT_V(8); PG8_WAIT_L(0); PG8_BAR; PG8_MMA(1, 0, At, B0); PG8_MMA(1, 1, At, B1); PG8_BAR; PG8_SCHED;
            PG8_LDB(B0, 1, 0); PG8_LDB(B1, 1, 1); PG8_SCHED; PG8_LDA(At, 1, 0); PG8_STAGE_A(PG8_SA(0, 1), a2, 1, last);
            PG8_WAIT_V(8); PG8_WAIT_L(0); PG8_BAR; PG8_MMA(0, 0, At, B0); PG8_MMA(0, 1, At, B1); PG8_BAR; PG8_SCHED;
            PG8_LDA(At, 1, 1); PG8_STAGE(PG8_SB(1, 0), b3, voffB); PG8_STAGE(PG8_SB(1, 1), b3 + hstep, voffB); PG8_STAGE_A(PG8_SA(1, 0), a3, 0, last);
            PG8_WAIT_V(8); PG8_WAIT_L(0); PG8_BAR; PG8_MMA(1, 0, At, B0); PG8_MMA(1, 1, At, B1); PG8_BAR; PG8_SCHED;
            } else {
            PG8_LDB(B0, 0, 0); PG8_SCHED; PG8_LDA(At, 0, 0); PG8_STAGE_A(PG8_SA(1, 1), a1, 1, false);
            PG8_WAIT_L(8); PG8_BAR; PG8_WAIT_L(0); PG8_MMA(0, 0, At, B0); PG8_BAR; PG8_SCHED;
            PG8_LDB(B1, 0, 1); PG8_STAGE(PG8_SB(0, 0), b2, voffB);
            PG8_BAR; PG8_WAIT_L(0); PG8_MMA(0, 1, At, B1); PG8_BAR;
            PG8_LDA(At, 0, 1); PG8_STAGE_A(PG8_SA(0, 0), a2, 0, last);
            PG8_BAR; PG8_WAIT_L(0); PG8_MMA(1, 0, At, B0); PG8_BAR; PG8_SCHED;
            PG8_STAGE(PG8_SB(0, 1), b2 + hstep, voffB);
            PG8_WAIT_V(6); PG8_BAR; PG8_MMA(1, 1, At, B1); PG8_BAR;
            PG8_LDB(B0, 1, 0); PG8_SCHED; PG8_LDA(At, 1, 0); PG8_STAGE_A(PG8_SA(0, 1), a2, 1, last);
            PG8_WAIT_L(8); PG8_BAR; PG8_WAIT_L(0); PG8_MMA(0, 0, At, B0); PG8_BAR; PG8_SCHED;
            PG8_LDB(B1, 1, 1); PG8_STAGE(PG8_SB(1, 0), b3, voffB);
            PG8_BAR; PG8_WAIT_L(0); PG8_MMA(0, 1, At, B1); PG8_BAR;
            PG8_LDA(At, 1, 1); PG8_STAGE_A(PG8_SA(1, 0), a3, 0, last);
            PG8_BAR; PG8_WAIT_L(0); PG8_MMA(1, 0, At, B0); PG8_BAR; PG8_SCHED;
            PG8_STAGE(PG8_SB(1, 1), b3 + hstep, voffB);
            PG8_WAIT_V(6); PG8_BAR; PG8_MMA(1, 1, At, B1); PG8_BAR;
            }
        }
        if constexpr (ALIGN_EPI) { if (wr == 0) PG8_BAR; }
        if constexpr (!Epi::AFTER_DRAIN) { E(acc, cur, wr, wc, fr, fq); S.done(cur); }
        if (!has_next) break;
#pragma unroll
        for (int a = 0; a < 2; ++a)
#pragma unroll
            for (int b = 0; b < 2; ++b)
#pragma unroll
                for (int m = 0; m < 4; ++m)
#pragma unroll
                    for (int n = 0; n < 2; ++n) acc[a][b][m][n] = (f32x4){0.f, 0.f, 0.f, 0.f};
        cur = nxt; cA = nA; cB = nB; ++ui; if constexpr (GATHER) { vc[0] = vn[0]; vc[1] = vn[1]; }
        if constexpr (ALIGN_EPI) { if (wr == 1) PG8_BAR; }
    }
    PG8_WAIT_V(0);
    if constexpr (!ALIGN_EPI) { if (wr == 0) PG8_BAR; }
    PG8_BAR;
    if constexpr (Epi::AFTER_DRAIN) { E.fused(acc, cur, wr, wc, fr, fq, lds, wid, lane); S.done(cur); }
#undef PG8_SA
#undef PG8_SB
#undef PG8_STAGE
#undef PG8_STAGE_A
#undef PG8_LDROWS
#undef PG8_LDA
#undef PG8_LDB
#undef PG8_MMA
#undef PG8_WAIT_V
#undef PG8_WAIT_L
#undef PG8_BAR
#undef PG8_SCHED
}}

namespace att {
#define ALAS __attribute__((address_space(3)))
typedef unsigned short bf16_t;
typedef short bf16x8 __attribute__((ext_vector_type(8)));
typedef short s16x4 __attribute__((ext_vector_type(4)));
typedef float f32x16 __attribute__((ext_vector_type(16)));
typedef unsigned u32x4 __attribute__((ext_vector_type(4)));
typedef float f32x2_t __attribute__((ext_vector_type(2))); typedef __bf16 bf16x2_t __attribute__((ext_vector_type(2)));
constexpr float THR = 8.0f;
constexpr int LROWS = 32768;
__device__ __forceinline__ int crow(int r, int hi) { return (r & 3) + 8 * (r >> 2) + 4 * hi; }
__device__ __forceinline__ unsigned cvtpk(float lo, float hi) { f32x2_t v = {lo, hi}; bf16x2_t b = __builtin_convertvector(v, bf16x2_t); return __builtin_bit_cast(unsigned, b); }
__device__ __forceinline__ unsigned short f2bf(float f) { unsigned u = __builtin_bit_cast(unsigned, f); return (unsigned short)((u + 0x7fffu + ((u >> 16) & 1u)) >> 16); }
typedef short v4i16_t __attribute__((ext_vector_type(4)));
__device__ __forceinline__ s16x4 vtr(const ALAS char* p) { return __builtin_bit_cast(s16x4, __builtin_amdgcn_ds_read_tr16_b64_v4i16((ALAS v4i16_t*)p)); }
template <int X> __device__ __forceinline__ float lane_xor32(float v) {
    if (X == 1) return __builtin_bit_cast(float, __builtin_amdgcn_update_dpp(0, __builtin_bit_cast(int, v), 0xB1, 0xF, 0xF, true));
    if (X == 2) return __builtin_bit_cast(float, __builtin_amdgcn_update_dpp(0, __builtin_bit_cast(int, v), 0x4E, 0xF, 0xF, true));
    return __builtin_bit_cast(float, __builtin_amdgcn_ds_swizzle(__builtin_bit_cast(int, v), (X << 10) | 0x1F));
}
__device__ __forceinline__ float half_sum32(float v) { v += lane_xor32<1>(v); v += lane_xor32<2>(v); v += lane_xor32<4>(v); v += lane_xor32<8>(v); v += lane_xor32<16>(v); return v; }
__device__ __forceinline__ float swapmax(float m) { auto rr = __builtin_amdgcn_permlane32_swap(__float_as_uint(m), __float_as_uint(m), false, false); return fmaxf(__uint_as_float(rr[0]), __uint_as_float(rr[1])); }
__device__ __forceinline__ float swapadd(float m) { auto rr = __builtin_amdgcn_permlane32_swap(__float_as_uint(m), __float_as_uint(m), false, false); return __uint_as_float(rr[0]) + __uint_as_float(rr[1]); }

__device__ __forceinline__ void glds16(const void* gsrc, unsigned lds_dst) {
    asm volatile("s_mov_b32 m0, %1\n\ts_nop 0\n\tglobal_load_lds_dwordx4 %0, off" :: "v"(gsrc), "s"(lds_dst) : "memory", "m0"); }
#define RFL(x) ((unsigned)__builtin_amdgcn_readfirstlane((int)(x)))
struct DmaA { const bf16_t* k; const bf16_t* v; unsigned sb; bool on;
    __device__ __forceinline__ void operator()(int i) const { if (on) { if (i == 0) glds16(k, RFL(sb)); if (i == 2) glds16(v, RFL(sb + 8192)); } } };
struct DmaB { const bf16_t* k; const bf16_t* v; unsigned sb; bool on;
    __device__ __forceinline__ void operator()(int i) const { if (on) { if (i == 0) glds16(k, RFL(sb)); if (i == 1) glds16(k + 64, RFL(sb + 8192)); if (i == 2) glds16(v, RFL(sb + 16384)); if (i == 3) glds16(v + 64, RFL(sb + 24576)); } } };
template <int DVB, class DMA>
__device__ __forceinline__ void step_y(const DMA& dma, const ALAS char* Vs, f32x16 (&o)[DVB], const u32x4 (&pw)[4], int lane, int hi) {
    const ALAS char* vp = Vs + ((lane >> 4) & 1) * 32 + (lane & 3) * 8 + (4 * hi + ((lane & 15) >> 2)) * 64;
    s16x4 va[8], vb[8];
#pragma unroll
    for (int ks = 0; ks < 4; ++ks) { va[2 * ks] = vtr(vp + ks * 1024); va[2 * ks + 1] = vtr(vp + ks * 1024 + 512); }
#pragma unroll
    for (int db = 0; db < DVB; ++db) {
        if (db + 1 < DVB) {
#pragma unroll
            for (int ks = 0; ks < 4; ++ks) { vb[2 * ks] = vtr(vp + (db + 1) * 4096 + ks * 1024); vb[2 * ks + 1] = vtr(vp + (db + 1) * 4096 + ks * 1024 + 512); }
        }
        __builtin_amdgcn_sched_barrier(0);
        __builtin_amdgcn_s_setprio(1);
#pragma unroll
        for (int ks = 0; ks < 4; ++ks) {
            const bf16x8 vf = (bf16x8){va[2 * ks][0], va[2 * ks][1], va[2 * ks][2], va[2 * ks][3], va[2 * ks + 1][0], va[2 * ks + 1][1], va[2 * ks + 1][2], va[2 * ks + 1][3]};
            o[db] = __builtin_amdgcn_mfma_f32_32x32x16_bf16(__builtin_bit_cast(bf16x8, pw[ks]), vf, o[db], 0, 0, 0);
        }
        __builtin_amdgcn_s_setprio(0);
        dma(DVB == 2 ? 2 * db : db);
        __builtin_amdgcn_sched_barrier(0);
        if (db + 1 < DVB) {
#pragma unroll
            for (int i = 0; i < 8; ++i) va[i] = vb[i];
        }
    }
}
template <bool MASK, bool PREV, class DMA>
__device__ __forceinline__ bool step_qk(const DMA& dma, const ALAS char* Ks, const ALAS char* Vs, s16x4 (&vlo)[4], s16x4 (&vhi)[4], const bf16x8 (&qr)[4], f32x16& p0, f32x16& p1, f32x16& negm, float& mhat, float& l, ALAS float* wsf, int lane, int r32, int hi, bool first, int mrel) {
    const ALAS char* kb = Ks + r32 * 128; const int sw = (r32 >> 1) & 7;
    bf16x8 kc0[4], kc1[4];
    { const int off = ((0 + hi) ^ sw) << 4; kc0[0] = *(const ALAS bf16x8*)(kb + off); kc1[0] = *(const ALAS bf16x8*)(kb + 4096 + off); }
#pragma unroll
    for (int d0 = 0; d0 < 4; ++d0) {
        if (d0 + 1 < 4) { const int off = ((2 * (d0 + 1) + hi) ^ sw) << 4; kc0[d0 + 1] = *(const ALAS bf16x8*)(kb + off); kc1[d0 + 1] = *(const ALAS bf16x8*)(kb + 4096 + off); }
        __builtin_amdgcn_sched_barrier(0);
        if (d0 == 0) { p0 = __builtin_amdgcn_mfma_f32_32x32x16_bf16(kc0[0], qr[0], negm, 0, 0, 0);
            asm volatile("v_mfma_f32_32x32x16_bf16 %0, %1, %2, %3" : "=&v"(p1) : "v"(kc1[0]), "v"(qr[0]), "v"(negm)); }
        else { p0 = __builtin_amdgcn_mfma_f32_32x32x16_bf16(kc0[d0], qr[d0], p0, 0, 0, 0); p1 = __builtin_amdgcn_mfma_f32_32x32x16_bf16(kc1[d0], qr[d0], p1, 0, 0, 0); }
        dma(d0);
    }
    if (PREV) {
        const ALAS char* vp = Vs + ((lane >> 4) & 1) * 32 + (lane & 3) * 8 + (4 * hi + ((lane & 15) >> 2)) * 64;
#pragma unroll
        for (int i = 0; i < 4; ++i) { vlo[i] = vtr(vp + i * 1024); vhi[i] = vtr(vp + i * 1024 + 512); }
    }
    if (MASK) {
#pragma unroll
        for (int r = 0; r < 16; ++r) { const int rel = mrel + crow(r, hi);
            if (rel < -128 || rel > 128) p0[r] = -INFINITY;
            if (rel + 32 < -128 || rel + 32 > 128) p1[r] = -INFINITY; }
    }
    float ma = fmaxf(fmaxf(p0[0], p0[1]), p1[0]), mb = fmaxf(fmaxf(p0[2], p0[3]), p1[1]);
    ma = fmaxf(fmaxf(ma, p1[2]), p1[3]);
#pragma unroll
    for (int r = 4; r < 16; r += 4) { ma = fmaxf(fmaxf(ma, p0[r]), p0[r + 1]); mb = fmaxf(fmaxf(mb, p0[r + 2]), p0[r + 3]); ma = fmaxf(fmaxf(ma, p1[r]), p1[r + 1]); mb = fmaxf(fmaxf(mb, p1[r + 2]), p1[r + 3]); }
    const float mx = swapmax(fmaxf(ma, mb));
    bool resc = false;
    if (first) {
        mhat = mx;
#pragma unroll
        for (int r = 0; r < 16; ++r) { p0[r] -= mx; p1[r] -= mx; negm[r] = -mx; }
    } else if (__any(mx > THR)) {
        const float dl = fmaxf(mx, 0.f); mhat += dl;
#pragma unroll
        for (int r = 0; r < 16; ++r) { p0[r] -= dl; p1[r] -= dl; negm[r] = -mhat; }
        const float f = __builtin_amdgcn_exp2f(-dl); l *= f;
        if (hi == 0) wsf[r32] = f;
        resc = true;
    }
    return resc;
}
#define ATT_EL(e) ((e) < 16 ? p0[(e) & 15] : p1[(e) & 15])
template <int DVB, bool DO_PV>
__device__ __forceinline__ void step_pv_sm(const ALAS char* Vs, s16x4 (&vlo)[4], s16x4 (&vhi)[4], f32x16 (&o)[DVB], const u32x4 (&pwo)[4], f32x16& p0, f32x16& p1, u32x4 (&pwn)[4], float& l, int lane, int hi) {
    float s0 = 0.f, s1 = 0.f; unsigned pk[16];
    if (!DO_PV) {
#pragma unroll
        for (int r = 0; r < 16; ++r) { p0[r] = __builtin_amdgcn_exp2f(p0[r]); p1[r] = __builtin_amdgcn_exp2f(p1[r]); s0 += p0[r]; s1 += p1[r]; }
#pragma unroll
        for (int t = 0; t < 16; ++t) pk[t] = cvtpk(ATT_EL(2 * t), ATT_EL(2 * t + 1));
    } else {
        constexpr int NM = DVB * 4, EPG = 32 / NM;
        const ALAS char* vp = Vs + ((lane >> 4) & 1) * 32 + (lane & 3) * 8 + (4 * hi + ((lane & 15) >> 2)) * 64;
        constexpr int LA = 4;
        __builtin_amdgcn_sched_barrier(0);
#pragma unroll
        for (int j = 0; j < NM; ++j) {
            const bf16x8 vf = (bf16x8){vlo[j % LA][0], vlo[j % LA][1], vlo[j % LA][2], vlo[j % LA][3], vhi[j % LA][0], vhi[j % LA][1], vhi[j % LA][2], vhi[j % LA][3]};
            o[j >> 2] = __builtin_amdgcn_mfma_f32_32x32x16_bf16(__builtin_bit_cast(bf16x8, pwo[j & 3]), vf, o[j >> 2], 0, 0, 0);
#pragma unroll
            for (int u = 0; u < EPG; ++u) { const int e = j * EPG + u;
                if (e < 16) { p0[e & 15] = __builtin_amdgcn_exp2f(p0[e & 15]); } else { p1[e & 15] = __builtin_amdgcn_exp2f(p1[e & 15]); } }
            if (j * EPG < 16) asm volatile("" : "+v"(p0) :: "memory"); else asm volatile("" : "+v"(p1) :: "memory");
            if (j + LA < NM) { vlo[j % LA] = vtr(vp + ((j + LA) >> 2) * 4096 + ((j + LA) & 3) * 1024); vhi[j % LA] = vtr(vp + ((j + LA) >> 2) * 4096 + ((j + LA) & 3) * 1024 + 512); }
            asm volatile("" ::: "memory");
            if (j > 0) {
#pragma unroll
                for (int u = 0; u < EPG; u += 2) { const int e = (j - 1) * EPG + u; s0 += ATT_EL(e); s1 += ATT_EL(e + 1); pk[e >> 1] = cvtpk(ATT_EL(e), ATT_EL(e + 1)); asm volatile("" : "+v"(pk[e >> 1])); }
                asm volatile("" : "+v"(s0), "+v"(s1));
            }
            asm volatile("" : "+v"(o[j >> 2]));
            __builtin_amdgcn_sched_barrier(0);
        }
#pragma unroll
        for (int u = 0; u < EPG; u += 2) { const int e = (NM - 1) * EPG + u; s0 += ATT_EL(e); s1 += ATT_EL(e + 1); pk[e >> 1] = cvtpk(ATT_EL(e), ATT_EL(e + 1)); }
    }
#pragma unroll
    for (int k = 0; k < 4; ++k) pwn[k] = (u32x4){pk[4 * k], pk[4 * k + 1], pk[4 * k + 2], pk[4 * k + 3]};
    l += s0 + s1;
}
#undef ATT_EL
template <int DVB> __device__ __forceinline__ void rescale_o(f32x16 (&o)[DVB], ALAS float* wsf, int hi) {
    float fr_[16];
#pragma unroll
    for (int r = 0; r < 16; ++r) fr_[r] = wsf[crow(r, hi)];
#pragma unroll
    for (int db = 0; db < DVB; ++db)
#pragma unroll
        for (int r = 0; r < 16; ++r) o[db][r] *= fr_[r];
}
#define ATT_WAIT_BAR(N) asm volatile("s_waitcnt vmcnt(" #N ") lgkmcnt(0)\n\ts_barrier" ::: "memory")
#define ATT_BAR() asm volatile("s_waitcnt lgkmcnt(0)\n\ts_barrier" ::: "memory")

constexpr int WSF_OFF = 131072, OST_OFF = 65536;

struct ADesc { int NW, NT, nlo, wrow0, crow0, qrow0, kvh; };
__device__ __forceinline__ ADesc a_desc(int L) {
    int pair, qb; if (L < 2048) { pair = L >> 5; qb = L & 31; } else { pair = (L - 2048) >> 2; qb = 32 + ((L - 2048) & 3); }
    const int b = pair >> 2; ADesc d; d.kvh = pair & 3;
    const bool lat = qb < 32; const int p0 = lat ? qb * 64 : 0;
    d.nlo = lat ? (p0 == 0 ? 2 : (p0 == 64 ? 1 : 0)) : 0; const int nhi = lat ? (p0 == 1984 ? 2 : (p0 == 1920 ? 3 : 4)) : -1;
    d.NW = lat ? (nhi - d.nlo + 1) : 0; d.NT = d.NW + 4;
    d.wrow0 = b * 2048 + p0 - 128 + 64 * d.nlo; d.crow0 = LROWS + b * 256;
    d.qrow0 = lat ? b * 2048 + p0 : LROWS + b * 256 + (qb - 32) * 64;
    return d;
}
__device__ __forceinline__ void phase_A(ALAS char* shm, const bf16_t* Q, const bf16_t* K, const bf16_t* V, bf16_t* O, const float* sink, int first, int step, int U) {
    int tid_ = threadIdx.x; asm volatile("" : "+v"(tid_));
    const int tid = tid_, lane = tid & 63, r32 = lane & 31, hi = lane >> 5; const int wid = __builtin_amdgcn_readfirstlane(tid >> 6);
    constexpr int STG = 16384, KVP = 256;
    if (first >= U) return;
    const int g = wid & 3, half = wid >> 2;
    const bf16_t* klane = K + (size_t)(8 * wid + (lane >> 3)) * KVP + (((lane & 7) ^ ((wid & 1) * 4 + (lane >> 4))) << 3);
    const bf16_t* vlane = V + (size_t)(16 * (wid & 3) + (lane >> 2)) * KVP + (wid >> 2) * 32 + (lane & 3) * 8;
    const unsigned dst0 = (unsigned)(uintptr_t)shm + wid * 1024;
    ALAS float* wsf = (ALAS float*)(shm + WSF_OFF) + wid * 64;
#define A_ROWOF(d, n) ((n) < (d).NW ? (d).wrow0 + 64 * (n) : (d).crow0 + 64 * ((n) - (d).NW))
#define A_QLOAD(dst, d) do { const bf16_t* Qw_ = Q + (size_t)((d).qrow0 + 32 * half + r32) * 1024 + ((d).kvh * 4 + g) * 64 + hi * 8; \
        _Pragma("unroll") for (int d0 = 0; d0 < 4; ++d0) dst[d0] = *(const bf16x8*)(Qw_ + d0 * 16); } while (0)
    int L = first; ADesc cur = a_desc(L); int gb = 0;
    bf16x8 qr[4], qn[4];
    A_QLOAD(qr, cur);
    { const size_t r0_ = (size_t)A_ROWOF(cur, 0) * KVP + cur.kvh * 64, r1_ = (size_t)A_ROWOF(cur, 1) * KVP + cur.kvh * 64;
      glds16(klane + r0_, RFL(dst0)); glds16(vlane + r0_, RFL(dst0 + 8192)); glds16(klane + r1_, RFL(dst0 + STG)); glds16(vlane + r1_, RFL(dst0 + STG + 8192)); }
    ATT_WAIT_BAR(2);
    for (;;) {
        const int Ln = L + step; const bool has_next = Ln < U; const ADesc nxt = has_next ? a_desc(Ln) : cur;
        const int NT = cur.NT, NW = cur.NW, nlo = cur.nlo, head = cur.kvh * 4 + g;
        float mhat = sink[head] * 1.4426950408889634f, l = (hi == 0) ? 1.0f : 0.0f;
        f32x16 o[2], negm;
#pragma unroll
        for (int r = 0; r < 16; ++r) { o[0][r] = 0.f; o[1][r] = 0.f; negm[r] = -mhat; }
        u32x4 pw[4], pwn[4]; f32x16 sp0, sp1; s16x4 vlo[4], vhi[4];
#define A_MKDMA(n) const int t_ = (n) + 2; const bool own_ = t_ < NT; const bool on_ = own_ || has_next; \
        const size_t ro_ = own_ ? (size_t)A_ROWOF(cur, t_) * KVP + cur.kvh * 64 : (size_t)A_ROWOF(nxt, t_ - NT) * KVP + nxt.kvh * 64; \
        const DmaA dma_{klane + ro_, vlane + ro_, dst0 + ((gb + t_) & 3) * STG, on_}
#define A_ENDBAR(n) do { if ((n) + 2 < NT || has_next) ATT_WAIT_BAR(2); else ATT_WAIT_BAR(0); } while (0)
#define A_QKSTEP(n, D, RES, PV_) do { const ALAS char* sb_ = shm + ((gb + (n)) & 3) * STG; const ALAS char* vs_ = shm + ((gb + (n) - 1) & 3) * STG + 8192; const int np_ = nlo + (n); \
        if ((n) < NW && (np_ == 0 || np_ == 4)) RES = step_qk<true, PV_>(D, sb_, vs_, vlo, vhi, qr, sp0, sp1, negm, mhat, l, wsf, lane, r32, hi, false, 64 * np_ - 128 - 32 * half - r32); \
        else RES = step_qk<false, PV_>(D, sb_, vs_, vlo, vhi, qr, sp0, sp1, negm, mhat, l, wsf, lane, r32, hi, false, 0); } while (0)
        { bool rs_; { A_MKDMA(0); A_QKSTEP(0, dma_, rs_, false); } step_pv_sm<2, false>(shm, vlo, vhi, o, pw, sp0, sp1, pwn, l, lane, hi); if (rs_) rescale_o<2>(o, wsf, hi);
#pragma unroll
          for (int i = 0; i < 4; ++i) pw[i] = pwn[i];
          A_ENDBAR(0); }
        for (int n = 1; n < NT; ++n) { bool rs_; { A_MKDMA(n); A_QKSTEP(n, dma_, rs_, true); }
            step_pv_sm<2, true>(shm + ((gb + n - 1) & 3) * STG + 8192, vlo, vhi, o, pw, sp0, sp1, pwn, l, lane, hi); if (rs_) rescale_o<2>(o, wsf, hi);
#pragma unroll
            for (int i = 0; i < 4; ++i) pw[i] = pwn[i];
            A_ENDBAR(n); }
        { const DmaA nodma{klane, vlane, 0u, false}; step_y<2>(nodma, shm + ((gb + NT - 1) & 3) * STG + 8192, o, pw, lane, hi); }
#undef A_MKDMA
#undef A_ENDBAR
#undef A_QKSTEP
        if (has_next) A_QLOAD(qn, nxt);
        l = swapadd(l);
        if (hi == 0) wsf[32 + r32] = l;
        float rli[16];
#pragma unroll
        for (int r = 0; r < 16; ++r) rli[r] = __builtin_amdgcn_rcpf(wsf[32 + crow(r, hi)]);
        ALAS unsigned short* stg = (ALAS unsigned short*)(shm + OST_OFF) + wid * 2048;
#pragma unroll
        for (int r = 0; r < 16; ++r) { const int orow = crow(r, hi);
#pragma unroll
            for (int db = 0; db < 2; ++db) stg[orow * 64 + db * 32 + r32] = f2bf(o[db][r] * rli[r]); }
        bf16_t* Ow = O + (size_t)(cur.qrow0 + 32 * half) * 1024 + head * 64;
#pragma unroll
        for (int i = 0; i < 4; ++i) { const int row = i * 8 + (lane >> 3), ch = lane & 7; const u32x4 v = *(const ALAS u32x4*)(stg + row * 64 + ch * 8); *(u32x4*)(Ow + (size_t)row * 1024 + ch * 8) = v; }
        if (!has_next) break;
        gb = (gb + NT) & 3; cur = nxt; L = Ln;
#pragma unroll
        for (int d0 = 0; d0 < 4; ++d0) qr[d0] = qn[d0];
    }
#undef A_ROWOF
#undef A_QLOAD
}

__device__ __forceinline__ void unit_B(ALAS char* shm, int b, int h, int qb, const bf16_t* Q, const bf16_t* K, const bf16_t* V, bf16_t* O, float lam, float osc, const float* subg) {
    int tid_ = threadIdx.x; asm volatile("" : "+v"(tid_));
    const int tid = tid_, lane = tid & 63, r32 = lane & 31, hi = lane >> 5; const int wid = __builtin_amdgcn_readfirstlane(tid >> 6);
    constexpr int STG = 32768, KVP = 1024;
    const bool lat = qb < 16;
    const int NW = lat ? 32 : 0, NT = NW + 4;
    const int wrow0 = b * 2048, crow0 = LROWS + b * 256;
    const int m = wid & 1, sub = wid >> 1;
    const int qrow = (lat ? b * 2048 + qb * 128 : LROWS + b * 256 + (qb - 16) * 128) + 32 * sub;
    const bf16_t* Qw = Q + (size_t)qrow * 1024 + h * 128 + m * 64;
    bf16x8 qr[4];
#pragma unroll
    for (int d0 = 0; d0 < 4; ++d0) qr[d0] = *(const bf16x8*)(Qw + (size_t)r32 * 1024 + d0 * 16 + hi * 8);
    const bf16_t* ksrc = K + (size_t)(8 * wid + (lane >> 3)) * KVP + h * 128 + (((lane & 7) ^ ((wid & 1) * 4 + (lane >> 4))) << 3);
    const bf16_t* vsrc = V + (size_t)(16 * (wid & 3) + (lane >> 2)) * KVP + h * 128 + (wid >> 2) * 32 + (lane & 3) * 8;
    const unsigned dst0 = (unsigned)(uintptr_t)shm + wid * 1024;
    ALAS float* wsf = (ALAS float*)(shm + WSF_OFF) + wid * 64;
    float mhat = 0.f, l = 0.f;
    f32x16 o[4], negm;
#pragma unroll
    for (int r = 0; r < 16; ++r) negm[r] = 0.f;
#pragma unroll
    for (int db = 0; db < 4; ++db)
#pragma unroll
        for (int r = 0; r < 16; ++r) o[db][r] = 0.f;
#define ROWOF(n) ((n) < NW ? wrow0 + 64 * (n) : crow0 + 64 * ((n) - NW))
#define DMA_TILE(t) do { const size_t ro_ = (size_t)ROWOF(t) * KVP; const unsigned sb_ = dst0 + ((t) & 3) * STG; \
        glds16(ksrc + ro_, RFL(sb_)); glds16(ksrc + ro_ + 64, RFL(sb_ + 8192)); glds16(vsrc + ro_, RFL(sb_ + 16384)); glds16(vsrc + ro_ + 64, RFL(sb_ + 24576)); } while (0)
    DMA_TILE(0); DMA_TILE(1);
    ATT_WAIT_BAR(4);
    u32x4 pw[4];
#define MKDMA(t) const int t_ = (t); const size_t ro_ = (size_t)ROWOF(t_ < NT ? t_ : NT - 1) * KVP; const DmaB dma_{ksrc + ro_, vsrc + ro_, dst0 + (t_ & 3) * STG, true}
#define YSTEP(n, D) step_y<4>(D, shm + ((n) & 3) * STG + 16384, o, pw, lane, hi)
#define ENDBAR(n) do { if ((n) + 1 < NT) ATT_WAIT_BAR(4); else ATT_WAIT_BAR(0); } while (0)
    const DmaB nodma{ksrc, vsrc, 0u, false};
    f32x16 sp0, sp1; u32x4 pwn[4]; s16x4 vlo[4], vhi[4];
    { bool rs_; { MKDMA(2); rs_ = step_qk<false, false>(dma_, shm + m * 8192, shm, vlo, vhi, qr, sp0, sp1, negm, mhat, l, wsf, lane, r32, hi, true, 0); } step_pv_sm<4, false>(shm, vlo, vhi, o, pw, sp0, sp1, pwn, l, lane, hi); (void)rs_;
#pragma unroll
      for (int i = 0; i < 4; ++i) pw[i] = pwn[i];
      ENDBAR(0); }
#define BSTEP(n, PWO, PWN) do { bool rs_; { MKDMA((n) + 2); rs_ = step_qk<false, true>(dma_, shm + ((n) & 3) * STG + m * 8192, shm + (((n) - 1) & 3) * STG + 16384, vlo, vhi, qr, sp0, sp1, negm, mhat, l, wsf, lane, r32, hi, false, 0); } \
        step_pv_sm<4, true>(shm + (((n) - 1) & 3) * STG + 16384, vlo, vhi, o, PWO, sp0, sp1, PWN, l, lane, hi); if (rs_) rescale_o<4>(o, wsf, hi); \
        ENDBAR(n); } while (0)
    for (int n = 1; n + 1 < NT; n += 2) { BSTEP(n, pw, pwn); BSTEP(n + 1, pwn, pw); }
    BSTEP(NT - 1, pw, pwn);
#pragma unroll
    for (int i = 0; i < 4; ++i) pw[i] = pwn[i];
#undef BSTEP
    YSTEP(NT - 1, nodma);
#undef MKDMA
#undef YSTEP
#undef ENDBAR
#undef ROWOF
#undef DMA_TILE
    l = swapadd(l);
    if (hi == 0) wsf[32 + r32] = l;
    float rli[16];
#pragma unroll
    for (int r = 0; r < 16; ++r) rli[r] = __builtin_amdgcn_rcpf(wsf[32 + crow(r, hi)]);
    ALAS float* cb = (ALAS float*)(shm + sub * 16384);
    if (m == 1) {
#pragma unroll
        for (int r = 0; r < 16; ++r) { const int orow = crow(r, hi); const float sc = rli[r] * lam;
#pragma unroll
            for (int db = 0; db < 4; ++db) cb[orow * 128 + db * 32 + r32] = o[db][r] * sc; }
    }
    __syncthreads();
    if (m == 0) {
        float ss[16];
#pragma unroll
        for (int r = 0; r < 16; ++r) { const int orow = crow(r, hi); float q = 0.f;
#pragma unroll
            for (int db = 0; db < 4; ++db) { const float x = o[db][r] * rli[r] - cb[orow * 128 + db * 32 + r32]; o[db][r] = x; q += x * x; }
            ss[r] = q; }
#pragma unroll
        for (int r = 0; r < 16; ++r) { const float q = half_sum32(ss[r]);
            ss[r] = osc * __builtin_amdgcn_rsqf(q * (1.0f / 128.0f) + 1e-5f); }
        float gsub[4];
#pragma unroll
        for (int db = 0; db < 4; ++db) gsub[db] = subg[db * 32 + r32];
        ALAS unsigned short* stg = (ALAS unsigned short*)(shm + OST_OFF) + sub * 4096;
#pragma unroll
        for (int r = 0; r < 16; ++r) { const int orow = crow(r, hi);
#pragma unroll
            for (int db = 0; db < 4; ++db) stg[orow * 128 + db * 32 + r32] = f2bf(o[db][r] * ss[r] * gsub[db]); }
        bf16_t* Ow = O + (size_t)qrow * 1024 + h * 128;
#pragma unroll
        for (int i = 0; i < 8; ++i) { const int row = i * 4 + (lane >> 4), ch = lane & 15; const u32x4 v = *(const ALAS u32x4*)(stg + row * 128 + ch * 8); *(u32x4*)(Ow + (size_t)row * 1024 + ch * 8) = v; }
    }
    __syncthreads();
}
#undef RFL
#undef ATT_WAIT_BAR
#undef ATT_BAR
#undef ALAS
}

#ifndef MK_PER_PHASE
#define MK_PER_PHASE 0
#endif
constexpr int NWAVES = 8;
constexpr int DM = 1024, NBATCH = 16, SEQ = 2048, CTXL = 256, LROWS = NBATCH * SEQ, CROWS = NBATCH * CTXL, MROWS = LROWS + CROWS, NEXP = 16, DEPTH = 4;
constexpr float DN_ALPHA = 1.6817928305074292f;
constexpr float LN_EPS = 1e-6f;
constexpr float QSCALE = 0.125f * 1.4426950408889634f;
constexpr int NPHASE = 2 + 8 * DEPTH;

constexpr size_t MiB = 1u << 20;
constexpr size_t WS_CTL = 0, CTL_ZERO_BYTES = 1 * MiB;
constexpr size_t WS_MOD = 1 * MiB;
constexpr size_t WS_ROPE = 3 * MiB;
constexpr size_t WS_TOKE = 4 * MiB;
constexpr size_t WS_TOKW = 4 * MiB + 512 * 1024;
constexpr size_t WS_TOKP = 5 * MiB;
constexpr size_t WS_BCNT = 5 * MiB + 512 * 1024;
constexpr size_t WS_META = 5 * MiB + 768 * 1024;
constexpr size_t WS_ROWL = 6 * MiB;
constexpr size_t WS_XC = 662 * MiB;
constexpr size_t WS_WQKVA = 16 * MiB, WS_WOA = 22 * MiB, WS_WQKVB = 26 * MiB, WS_WOB = 38 * MiB;
constexpr size_t WS_WGU = 42 * MiB;
constexpr size_t WS_WDN = 170 * MiB;
constexpr size_t WS_HL = 234 * MiB;
constexpr size_t WS_Q = 306 * MiB, WS_K = 378 * MiB, WS_V = 450 * MiB;
constexpr size_t WS_XG = 306 * MiB;
constexpr size_t WS_AL = 522 * MiB;
constexpr size_t WS_XB = 598 * MiB;
constexpr size_t WS_END = 670 * MiB;
constexpr int CW_BAR = 4096;

constexpr int RING_BYTES = 135168, MISC_OFF = RING_BYTES, ROWTAB_OFF = 137216  , LDS_BYTES = 147456;

#define GAS __attribute__((address_space(1)))
#define LAS __attribute__((address_space(3)))
typedef unsigned short bf16;
typedef float f32x4 __attribute__((ext_vector_type(4)));
typedef unsigned u32x4 __attribute__((ext_vector_type(4)));
typedef unsigned u32x2 __attribute__((ext_vector_type(2)));
typedef GAS unsigned gu32;
#define RLX_AGENT __ATOMIC_RELAXED, __HIP_MEMORY_SCOPE_AGENT
#define LDS_WAIT() asm volatile("s_waitcnt lgkmcnt(0)" ::: "memory")
__device__ __forceinline__ unsigned f2bf(float f) { unsigned u = __builtin_bit_cast(unsigned, f); return (u + 0x7fffu + ((u >> 16) & 1u)) >> 16; }
typedef float pk_f32x2 __attribute__((ext_vector_type(2))); typedef __bf16 pk_bf16x2 __attribute__((ext_vector_type(2)));
__device__ __forceinline__ unsigned pk2(float lo, float hi) { pk_f32x2 v = {lo, hi}; pk_bf16x2 b = __builtin_convertvector(v, pk_bf16x2); return __builtin_bit_cast(unsigned, b); }
__device__ __forceinline__ float bflo(unsigned w) { return __uint_as_float(w << 16); }
__device__ __forceinline__ float bfhi(unsigned w) { return __uint_as_float(w & 0xffff0000u); }

#define XB_TMO      128
#define XB_XCNT(j)  (256  + 64 * (j))
#define XB_XSUB(j)  (1280 + 64 * (j))
#define XB_XGEN(j)  (2304 + 64 * (j))
#define XB_TOP      3328
#define XB_TOPGEN   3392
#define XCD_BAR_WORDS 3456
#define XB_SPIN_CAP (1u << 18)
__device__ __forceinline__ unsigned xb_ld(unsigned* p)              { return __hip_atomic_load(p, __ATOMIC_RELAXED, __HIP_MEMORY_SCOPE_AGENT); }
__device__ __forceinline__ unsigned xb_add(unsigned* p, unsigned v) { return __hip_atomic_fetch_add(p, v, __ATOMIC_RELAXED, __HIP_MEMORY_SCOPE_AGENT); }
__device__ __forceinline__ unsigned xb_xcc_id() { return (unsigned)__builtin_amdgcn_s_getreg((3 << 11) | 20) & 0xFu; }
#define XB_SPIN(cond, bar) do { unsigned _sp = 0; while (cond) { __builtin_amdgcn_s_sleep(1); \
    if ((++_sp & 255u) == 0u) { if (xb_ld(&(bar)[XB_TMO])) break; if (_sp > XB_SPIN_CAP) { atomicAdd(&(bar)[XB_TMO], 1u); break; } } } } while (0)
struct XcdBarrier { unsigned* bar; unsigned x; volatile LAS unsigned* st; };
__device__ __forceinline__ XcdBarrier xcd_barrier_post(unsigned* bar, volatile LAS unsigned* st) {
    XcdBarrier b; b.bar = bar; b.x = xb_xcc_id(); b.st = st;
    if (threadIdx.x == 0) (void)xb_add(&bar[XB_XCNT(b.x)], 1u);
    return b;
}
__device__ __forceinline__ void xcd_barrier_complete(unsigned* bar, unsigned x, unsigned& nloc, unsigned& nx) {
    const unsigned G = gridDim.x * gridDim.y * gridDim.z;
    unsigned sum, cnt, mine, sp = 0u;
    for (;;) {
        sum = 0u; cnt = 0u; mine = 0u;
#pragma unroll
        for (unsigned j = 0; j < 16; ++j) { const unsigned c = xb_ld(&bar[XB_XCNT(j)]); sum += c; cnt += (c > 0u) ? 1u : 0u; mine = (j == x) ? c : mine; }
        if (sum == G) break;
        __builtin_amdgcn_s_sleep(1);
        if ((++sp & 255u) == 0u) { if (xb_ld(&bar[XB_TMO])) break; if (sp > XB_SPIN_CAP) { atomicAdd(&bar[XB_TMO], 1u); break; } }
    }
    nloc = mine > 0u ? mine : 1u; nx = cnt > 0u ? cnt : 1u;
}
__device__ __forceinline__ void xcd_barrier(const XcdBarrier& b) {
    asm volatile("s_waitcnt vmcnt(0)" ::: "memory");
    __syncthreads();
    if (threadIdx.x == 0) {
        unsigned* bar = b.bar;
        __builtin_amdgcn_s_waitcnt(0);
        unsigned nloc = b.st[0], nx = b.st[1];
        if (nloc == 0u) { xcd_barrier_complete(bar, b.x, nloc, nx); b.st[0] = nloc; b.st[1] = nx; }
        const unsigned old = xb_add(&bar[XB_XSUB(b.x)], 1u);
        const unsigned gen = old / nloc;
        if (old + 1u == (gen + 1u) * nloc) {
            __builtin_amdgcn_fence(__ATOMIC_RELEASE, "agent");
            asm volatile("s_waitcnt vmcnt(0)" ::: "memory");
            const unsigned og = xb_add(&bar[XB_TOP], 1u);
            const unsigned tg = og / nx;
            if (og + 1u == (tg + 1u) * nx) xb_add(&bar[XB_TOPGEN], 1u);
            else XB_SPIN(xb_ld(&bar[XB_TOPGEN]) == tg, bar);
            __builtin_amdgcn_fence(__ATOMIC_ACQUIRE, "agent");
            xb_add(&bar[XB_XGEN(b.x)], 1u);
            asm volatile("s_waitcnt vmcnt(0)" ::: "memory");
        } else {
            XB_SPIN(xb_ld(&bar[XB_XGEN(b.x)]) == gen, bar);
            __builtin_amdgcn_fence(__ATOMIC_ACQUIRE, "agent");
            asm volatile("s_waitcnt vmcnt(0)" ::: "memory");
        }
    }
    __syncthreads();
}

struct Args { const float* in[22]; float* out; unsigned char* ws; int ph_lo, ph_hi; };

typedef const float* CFP_; typedef __attribute__((address_space(4))) const CFP_* KIn;
struct Frame {
    LAS unsigned char* lds; volatile LAS unsigned* MISC;
    int tid, lane, wave, vcu, G, gw, NGW, rpw;
    KIn in; float* out; unsigned char* ws;
};
__device__ __forceinline__ void fresh_in(Frame& F) { KIn p = (KIn)__builtin_amdgcn_kernarg_segment_ptr(); asm volatile("" : "+s"(p)); F.in = p; }

template <int X> __device__ __forceinline__ float lane_xor(float v) {
    if (X == 1) return __builtin_bit_cast(float, __builtin_amdgcn_update_dpp(0, __builtin_bit_cast(int, v), 0xB1, 0xF, 0xF, true));
    if (X == 2) return __builtin_bit_cast(float, __builtin_amdgcn_update_dpp(0, __builtin_bit_cast(int, v), 0x4E, 0xF, 0xF, true));
    return __builtin_bit_cast(float, __builtin_amdgcn_ds_swizzle(__builtin_bit_cast(int, v), (X << 10) | 0x1F));
}
template <int N> __device__ __forceinline__ float dpp_ror(float v) { return __builtin_bit_cast(float, __builtin_amdgcn_update_dpp(0, __builtin_bit_cast(int, v), 0x120 | N, 0xF, 0xF, true)); }
__device__ __forceinline__ float row_sum16(float v) { v += dpp_ror<8>(v); v += dpp_ror<4>(v); v += dpp_ror<2>(v); v += dpp_ror<1>(v); return v; }
__device__ __forceinline__ float half_sum(float v) { v = row_sum16(v);
    auto rr = __builtin_amdgcn_permlane16_swap(__float_as_uint(v), __float_as_uint(v), false, false); return __uint_as_float(rr[0]) + __uint_as_float(rr[1]); }
__device__ __forceinline__ float wave_sum(float v) {
    v = half_sum(v);
    auto rr = __builtin_amdgcn_permlane32_swap(__float_as_uint(v), __float_as_uint(v), false, false);
    return __uint_as_float(rr[0]) + __uint_as_float(rr[1]);
}
template <int MAP> __device__ __forceinline__ int map_row(int n) {
    if (MAP == 1) return (n & ~31) + 2 * (n & 15) + ((n >> 4) & 1);
    if (MAP == 2) return 8 * (n >> 2) + (n & 3);
    if (MAP == 3) return 8 * (n >> 2) + 4 + (n & 3);
    return n;
}
template <int MAP> __device__ __forceinline__ void transpose_item(const float* W, int K, int N, bf16* WT, LAS unsigned* scr, int item, int lane) {
    const int nblk = N / 64, kb = item / nblk, nb = item % nblk, k0 = 64 * kb, n0 = 64 * nb;
    const GAS float* src = (const GAS float*)W + (size_t)k0 * N + n0 + lane;
    float v[64];
#pragma unroll
    for (int t = 0; t < 64; ++t) v[t] = src[(size_t)t * N];
#pragma unroll
    for (int t = 0; t < 32; ++t) scr[lane * 33 + t] = pk2(v[2 * t], v[2 * t + 1]);
    LDS_WAIT(); asm volatile("" ::: "memory");
#pragma unroll
    for (int j = 0; j < 8; ++j) { const int row = j * 8 + (lane >> 3), ch = lane & 7; const LAS unsigned* sp = scr + row * 33 + ch * 4;
        u32x4 o; o.x = sp[0]; o.y = sp[1]; o.z = sp[2]; o.w = sp[3];
        *(GAS u32x4*)(WT + (size_t)map_row<MAP>(n0 + row) * K + k0 + ch * 8) = o; }
    LDS_WAIT(); asm volatile("" ::: "memory");
}
__device__ __forceinline__ void sincos_small(float x, float& s, float& c) {
    const float kf = rintf(x * 0.636619772367581f); const int k = (int)kf;
    float r = fmaf(-kf, 1.5703125f, x); r = fmaf(-kf, 4.837512969970703125e-4f, r); r = fmaf(-kf, 7.54978995489188216e-8f, r);
    const float r2 = r * r;
    const float sp = r + r * r2 * (-1.6666654611e-1f + r2 * (8.3321608736e-3f + r2 * (-1.9515295891e-4f)));
    const float cp = 1.0f - 0.5f * r2 + r2 * r2 * (4.166664568298827e-2f + r2 * (-1.388731625493765e-3f + r2 * 2.443315711809948e-5f));
    const int q = k & 3;
    s = (q == 0) ? sp : (q == 1) ? cp : (q == 2) ? -sp : -cp;
    c = (q == 0) ? cp : (q == 1) ? -sp : (q == 2) ? -cp : sp;
}

__device__ __forceinline__ void convert_experts(Frame& F, int layer, int w, int nw) {
    fresh_in(F);
    int t_ = threadIdx.x; asm volatile("" : "+v"(t_)); const int lane = t_ & 63;
    LAS unsigned* scr = (LAS unsigned*)(F.lds + F.wave * 16384);
    bf16* wgu = (bf16*)(F.ws + WS_WGU); bf16* wdn = (bf16*)(F.ws + WS_WDN);
    constexpr int I_G = 16 * 8, I_D = 8 * 16, N_G = 16 * I_G, N_D = 16 * I_D;
    for (int it = w; it < 2 * N_G + N_D; it += nw) {
        int r = it;
        if (r < N_G) { const int mi = layer * 16 + r / I_G, ii = r % I_G; transpose_item<2>(F.in[19] + (size_t)mi * 1024 * 512, 1024, 512, wgu + (size_t)mi * 1024 * 1024, scr, ii, lane); continue; } r -= N_G;
        if (r < N_G) { const int mi = layer * 16 + r / I_G, ii = r % I_G; transpose_item<3>(F.in[20] + (size_t)mi * 1024 * 512, 1024, 512, wgu + (size_t)mi * 1024 * 1024, scr, ii, lane); continue; } r -= N_G;
        { const int mi = layer * 16 + r / I_D, ii = r % I_D; transpose_item<0>(F.in[21] + (size_t)mi * 512 * 1024, 512, 1024, wdn + (size_t)mi * 1024 * 512, scr, ii, lane); }
    }
}
template <int NB> __device__ __forceinline__ void adaln_gemv(Frame& F, int task_lo, int task_hi, int w, int nw) {
    { int t_ = threadIdx.x; asm volatile("" : "+v"(t_)); F.tid = t_; F.lane = t_ & 63; fresh_in(F); }
    const float* c = F.in[1]; const float* cctx = F.in[3]; const float* w_ada = F.in[4]; const float* b_ada = F.in[5];
    float* mod = (float*)(F.ws + WS_MOD);
    for (int task = task_lo + w; task < task_hi; task += nw) {
        const int li = task / 48, jc = task % 48;
        LAS float* s = (LAS float*)F.lds;
        LAS float* part = (LAS float*)(F.lds + 17 * 1024 * 4);
        for (int idx = F.tid; idx < 17 * 1024; idx += NWAVES * 64) { const int r = idx >> 10, k = idx & 1023; const float v = r < 16 ? c[r * 1024 + k] : cctx[k]; s[idx] = v / (1.0f + expf(-v)); }
        __syncthreads();
        const int ch = F.wave & 1, kq = F.wave >> 1, j = jc * 128 + ch * 64 + F.lane;
        const float* wu = w_ada + ((size_t)li * 1024 + kq * 256) * 6144 + jc * 128 + ch * 64;
        float acc[17];
#pragma unroll
        for (int r = 0; r < 17; ++r) acc[r] = 0.f;
        for (int kb = 0; kb < 256 / NB; ++kb) {
            float wv[NB];
#pragma unroll
            for (int t = 0; t < NB; ++t) wv[t] = wu[(size_t)(NB * kb + t) * 6144 + F.lane];
            __builtin_amdgcn_sched_barrier(0);
#pragma unroll
            for (int k4 = 0; k4 < NB / 4; ++k4)
#pragma unroll
                for (int r = 0; r < 17; ++r) { const f32x4 sv = *(const LAS f32x4*)(s + r * 1024 + kq * 256 + NB * kb + 4 * k4);
                    acc[r] = fmaf(sv[0], wv[4 * k4], acc[r]); acc[r] = fmaf(sv[1], wv[4 * k4 + 1], acc[r]); acc[r] = fmaf(sv[2], wv[4 * k4 + 2], acc[r]); acc[r] = fmaf(sv[3], wv[4 * k4 + 3], acc[r]); }
            __builtin_amdgcn_sched_barrier(0);
        }
#pragma unroll
        for (int r = 0; r < 17; ++r) part[(kq * 17 + r) * 128 + ch * 64 + F.lane] = acc[r];
        __syncthreads();
        for (int idx = F.tid; idx < 17 * 128; idx += NWAVES * 64) { const int r = idx >> 7, jj = idx & 127;
            const float v = (part[(0 * 17 + r) * 128 + jj] + part[(1 * 17 + r) * 128 + jj]) + (part[(2 * 17 + r) * 128 + jj] + part[(3 * 17 + r) * 128 + jj]);
            mod[((size_t)li * 17 + r) * 6144 + jc * 128 + jj] = v + b_ada[li * 6144 + jc * 128 + jj]; }
        __syncthreads();
    }
}

__device__ __forceinline__ void ph_prologue(Frame F) {
    { int t_ = threadIdx.x; asm volatile("" : "+v"(t_)); F.tid = t_; F.lane = t_ & 63; fresh_in(F); }
    adaln_gemv<32>(F, 0, 48, F.vcu, F.G);
    {
        float* rope = (float*)(F.ws + WS_ROPE);
        for (int idx = F.gw * 64 + F.lane; idx < 2048 * 32; idx += F.NGW * 64) { const int pos = idx >> 5, pi = idx & 31, j = pi & 15;
            const float ax = (float)(pi < 16 ? (pos >> 6) : (pos & 63)); const float inv = exp2f(-(float)j * (13.287712379549449f / 16.0f));
            float sn, cs; sincos_small(ax * inv, sn, cs); rope[idx * 2] = cs; rope[idx * 2 + 1] = sn; }
    }
    LAS unsigned* scr = (LAS unsigned*)(F.lds + F.wave * 16384);
    bf16* wqa = (bf16*)(F.ws + WS_WQKVA); bf16* woa = (bf16*)(F.ws + WS_WOA); bf16* wqb = (bf16*)(F.ws + WS_WQKVB); bf16* wob = (bf16*)(F.ws + WS_WOB);
    constexpr int I_QA = 16 * 24, I_O = 16 * 16, I_QB = 16 * 48;
    constexpr int N_QA = 2 * I_QA, N_OA = 2 * I_O, N_QB = 2 * I_QB, N_OB = 2 * I_O;
    constexpr int NITEMS = N_QA + N_OA + N_QB + N_OB;
    for (int it = F.gw; it < NITEMS; it += F.NGW) {
        int r = it;
        if (r < N_QA) { const int mi = r / I_QA, ii = r % I_QA; const int nb = ii % 24;
            if (nb < 20) transpose_item<1>(F.in[6] + (size_t)mi * 1024 * 1536, 1024, 1536, wqa + (size_t)mi * 1536 * 1024, scr, ii, F.lane);
            else transpose_item<0>(F.in[6] + (size_t)mi * 1024 * 1536, 1024, 1536, wqa + (size_t)mi * 1536 * 1024, scr, ii, F.lane);
            continue; } r -= N_QA;
        if (r < N_OA) { const int mi = r / I_O, ii = r % I_O; transpose_item<0>(F.in[7] + (size_t)mi * 1024 * 1024, 1024, 1024, woa + (size_t)mi * 1024 * 1024, scr, ii, F.lane); continue; } r -= N_OA;
        if (r < N_QB) { const int mi = r / I_QB, ii = r % I_QB; const int nb = ii % 48;
            if (nb < 32) transpose_item<1>(F.in[9] + (size_t)mi * 1024 * 3072, 1024, 3072, wqb + (size_t)mi * 3072 * 1024, scr, ii, F.lane);
            else transpose_item<0>(F.in[9] + (size_t)mi * 1024 * 3072, 1024, 3072, wqb + (size_t)mi * 3072 * 1024, scr, ii, F.lane);
            continue; } r -= N_QB;
        { const int mi = r / I_O, ii = r % I_O; transpose_item<0>(F.in[10] + (size_t)mi * 1024 * 1024, 1024, 1024, wob + (size_t)mi * 1024 * 1024, scr, ii, F.lane); }
    }
}

__device__ __forceinline__ void ld_f32(const float* p, int lane, f32x4 (&v)[4]) {
#pragma unroll
    for (int j = 0; j < 4; ++j) v[j] = ((const GAS f32x4*)p)[64 * j + lane];
}
__device__ __forceinline__ void ld_bf16(const bf16* p, int lane, f32x4 (&v)[4]) {
#pragma unroll
    for (int j = 0; j < 4; ++j) { const u32x2 w = ((const GAS u32x2*)p)[64 * j + lane]; v[j] = (f32x4){bflo(w.x), bfhi(w.x), bflo(w.y), bfhi(w.y)}; }
}
__device__ __forceinline__ void st_f32(float* p, int lane, const f32x4 (&v)[4]) {
#pragma unroll
    for (int j = 0; j < 4; ++j) ((GAS f32x4*)p)[64 * j + lane] = v[j];
}
__device__ __forceinline__ void st_bf16(bf16* p, int lane, const f32x4 (&v)[4]) {
#pragma unroll
    for (int j = 0; j < 4; ++j) { u32x2 w; w.x = pk2(v[j][0], v[j][1]); w.y = pk2(v[j][2], v[j][3]); ((GAS u32x2*)p)[64 * j + lane] = w; }
}
__device__ __forceinline__ void ln_core(f32x4 (&v)[4]) {
    float s = 0.f;
#pragma unroll
    for (int j = 0; j < 4; ++j) s += (v[j][0] + v[j][1]) + (v[j][2] + v[j][3]);
    const float mean = wave_sum(s) * (1.0f / DM); float q = 0.f;
#pragma unroll
    for (int j = 0; j < 4; ++j) { v[j] = v[j] - mean; q += (v[j][0] * v[j][0] + v[j][1] * v[j][1]) + (v[j][2] * v[j][2] + v[j][3] * v[j][3]); }
    const float rstd = __builtin_amdgcn_rsqf(wave_sum(q) * (1.0f / DM) + LN_EPS);
#pragma unroll
    for (int j = 0; j < 4; ++j) v[j] = v[j] * rstd;
}

__device__ __forceinline__ void ph_hl0(Frame F) {
    { int t_ = threadIdx.x; asm volatile("" : "+v"(t_)); F.tid = t_; F.lane = t_ & 63; fresh_in(F); }
    const float* mod = (const float*)(F.ws + WS_MOD); bf16* HL = (bf16*)(F.ws + WS_HL);
    const int r0 = F.gw * F.rpw, r1 = min(r0 + F.rpw, MROWS);
    int bcur = -1; f32x4 sc[4], sh[4], v[4], nx[4];
    if (r0 < r1) ld_f32(r0 < LROWS ? F.in[0] + (size_t)r0 * DM : F.in[2] + (size_t)(r0 - LROWS) * DM, F.lane, v);
    for (int row = r0; row < r1; ++row) {
        const int b = row < LROWS ? row >> 11 : 16;
        if (b != bcur) { bcur = b; const float* mb = mod + ((size_t)0 * 17 + b) * 6144; ld_f32(mb, F.lane, sh); ld_f32(mb + 1024, F.lane, sc); }
        if (row + 1 < r1) { const int rn = row + 1; ld_f32(rn < LROWS ? F.in[0] + (size_t)rn * DM : F.in[2] + (size_t)(rn - LROWS) * DM, F.lane, nx); }
        st_bf16((bf16*)(F.ws + WS_XB) + (size_t)row * DM, F.lane, v);
#pragma unroll
        for (int j = 0; j < 4; ++j) v[j] = v[j] * (sc[j] + 1.0f) + sh[j];
        st_bf16(HL + (size_t)row * DM, F.lane, v);
#pragma unroll
        for (int j = 0; j < 4; ++j) v[j] = nx[j];
    }
}

__device__ __forceinline__ void ph_ln1(Frame F, int li, int Mr) {
    { int t_ = threadIdx.x; asm volatile("" : "+v"(t_)); F.tid = t_; F.lane = t_ & 63; fresh_in(F); }
    const float* mod = (const float*)(F.ws + WS_MOD);
    const bf16* AL = (const bf16*)(F.ws + WS_AL); bf16* H2 = (bf16*)(F.ws + WS_HL);
    int* toke = (int*)(F.ws + WS_TOKE); float* tokw = (float*)(F.ws + WS_TOKW); int* bcnt = (int*)(F.ws + WS_BCNT);
    bf16* xb = (bf16*)(F.ws + WS_XB); static_assert(WS_XC == WS_XB + (size_t)LROWS * DM * 2, "context rows follow the latent rows");
    LAS float* wr = (LAS float*)F.lds;
    { const float* wrg = F.in[17];
      for (int idx = F.tid; idx < 1024 * 16; idx += NWAVES * 64) { const int k = idx >> 4, e = idx & 15; const int j = k >> 8, ln = (k & 255) >> 2, cc = k & 3, q = e >> 2, t = e & 3;
          wr[((((j * 4 + cc) * 4 + q) * 64 + ln) << 2) + t] = wrg[idx]; } }
    if (F.tid < 16) F.MISC[16 + F.tid] = 0u;
    __syncthreads();
    const int qg = F.lane >> 4;
    float rb4[4];
#pragma unroll
    for (int i = 0; i < 4; ++i) rb4[i] = F.in[18][4 * qg + i];
    f32x4 lg[4], lb[4]; ld_f32(F.in[13] + li * DM, F.lane, lg); ld_f32(F.in[14] + li * DM, F.lane, lb);
    const int wb = F.vcu * NWAVES * F.rpw, we = min(wb + NWAVES * F.rpw, Mr), ppw = (((we - wb) >> 1) + NWAVES - 1) / NWAVES;
    const int r0 = wb + 2 * F.wave * ppw, r1 = min(r0 + 2 * ppw, we);
    int bcur = -1; f32x4 g1[4], sc2[4], sh2[4]; u32x2 nv[4], na[4];
#define LN1_LDX(R) do { const int rn_ = (R); const bf16* xs_ = xb + (size_t)rn_ * DM; \
        _Pragma("unroll") for (int j = 0; j < 4; ++j) { nv[j] = ((const GAS u32x2*)xs_)[64 * j + F.lane]; na[j] = ((const GAS u32x2*)(AL + (size_t)rn_ * DM))[64 * j + F.lane]; } } while (0)
    if (r0 < r1) LN1_LDX(r0);
    typedef float f32x2p __attribute__((ext_vector_type(2)));
    for (int row0 = r0; row0 < r1; row0 += 2) {
        f32x4 h[2][4];
        { const int b = row0 < LROWS ? row0 >> 11 : 16;
            if (b != bcur) { bcur = b; const float* mb = mod + ((size_t)li * 17 + b) * 6144; ld_f32(mb + 2048, F.lane, g1); ld_f32(mb + 3072, F.lane, sh2); ld_f32(mb + 4096, F.lane, sc2);
#pragma unroll
                for (int j = 0; j < 4; ++j) sc2[j] = sc2[j] + 1.0f; } }
#pragma unroll
        for (int s = 0; s < 2; ++s) {
            const int row = row0 + s;
            bf16* xo = xb + (size_t)row * DM;
            f32x4 v[4];
#pragma unroll
            for (int j = 0; j < 4; ++j) v[j] = (f32x4){bflo(nv[j].x), bfhi(nv[j].x), bflo(nv[j].y), bfhi(nv[j].y)} * DN_ALPHA + g1[j] * (f32x4){bflo(na[j].x), bfhi(na[j].x), bflo(na[j].y), bfhi(na[j].y)};
            if (row0 + s + 1 < r1) LN1_LDX(row0 + s + 1);
            ln_core(v);
#pragma unroll
            for (int j = 0; j < 4; ++j) v[j] = v[j] * lg[j] + lb[j];
            st_bf16(xo, F.lane, v);
#pragma unroll
            for (int j = 0; j < 4; ++j) v[j] = v[j] * sc2[j] + sh2[j];
            st_bf16(H2 + (size_t)row * DM, F.lane, v);
#pragma unroll
            for (int j = 0; j < 4; ++j) h[s][j] = v[j];
        }
        f32x2p lgA[8], lgB[8];
#pragma unroll
        for (int e = 0; e < 8; ++e) { lgA[e] = (f32x2p){0.f, 0.f}; lgB[e] = (f32x2p){0.f, 0.f}; }
#pragma unroll
        for (int j = 0; j < 4; ++j) {
#pragma unroll
            for (int hf = 0; hf < 2; ++hf) {
                f32x4 w4[8];
#pragma unroll
                for (int i = 0; i < 8; ++i) w4[i] = *(const LAS f32x4*)(wr + (((j * 16 + hf * 8 + i) * 64 + F.lane) << 2));
                __builtin_amdgcn_sched_barrier(0);
#pragma unroll
                for (int c2 = 0; c2 < 2; ++c2) { const int cc = hf * 2 + c2; const f32x2p ha = (f32x2p){h[0][j][cc], h[0][j][cc]}, hb = (f32x2p){h[1][j][cc], h[1][j][cc]};
#pragma unroll
                    for (int q = 0; q < 4; ++q) { const f32x4 w = w4[c2 * 4 + q]; const f32x2p wl = (f32x2p){w[0], w[1]}, wh = (f32x2p){w[2], w[3]};
                        lgA[2 * q] = __builtin_elementwise_fma(ha, wl, lgA[2 * q]); lgA[2 * q + 1] = __builtin_elementwise_fma(ha, wh, lgA[2 * q + 1]);
                        lgB[2 * q] = __builtin_elementwise_fma(hb, wl, lgB[2 * q]); lgB[2 * q + 1] = __builtin_elementwise_fma(hb, wh, lgB[2 * q + 1]); } }
#pragma unroll
                for (int e = 0; e < 8; ++e) asm volatile("" : "+v"(lgA[e]), "+v"(lgB[e]));
                __builtin_amdgcn_sched_barrier(0);
            }
        }
#pragma unroll
        for (int s = 0; s < 2; ++s) {
            const int row = row0 + s;
            float lgt[16];
#pragma unroll
            for (int e = 0; e < 8; ++e) { lgt[2 * e] = s ? lgB[e][0] : lgA[e][0]; lgt[2 * e + 1] = s ? lgB[e][1] : lgA[e][1]; }
            float y8[8];
#pragma unroll
            for (int e = 0; e < 8; ++e) { auto rr = __builtin_amdgcn_permlane32_swap(__float_as_uint(lgt[e]), __float_as_uint(lgt[e + 8]), false, false); y8[e] = __uint_as_float(rr[0]) + __uint_as_float(rr[1]); }
            float z[4];
#pragma unroll
            for (int i = 0; i < 4; ++i) { auto rr = __builtin_amdgcn_permlane16_swap(__float_as_uint(y8[i]), __float_as_uint(y8[i + 4]), false, false); z[i] = __uint_as_float(rr[0]) + __uint_as_float(rr[1]); }
#pragma unroll
            for (int i = 0; i < 4; ++i) z[i] = row_sum16(z[i]);
            float sg[4], bs[4];
#pragma unroll
            for (int i = 0; i < 4; ++i) { sg[i] = __builtin_amdgcn_rcpf(1.0f + __builtin_amdgcn_exp2f(-1.4426950408889634f * z[i])); bs[i] = sg[i] + rb4[i]; }
            float m0 = bs[0], v0 = sg[0]; int i0 = 0;
#pragma unroll
            for (int t = 1; t < 4; ++t) if (bs[t] > m0) { m0 = bs[t]; v0 = sg[t]; i0 = t; }
            float m1 = -INFINITY, v1 = 0.f; int i1 = 0;
#pragma unroll
            for (int t = 0; t < 4; ++t) if (t != i0 && bs[t] > m1) { m1 = bs[t]; v1 = sg[t]; i1 = t; }
            float bestg = m0 + m1, s0 = v0, s1 = v1; int epk = (4 * qg + i0) | ((4 * qg + i1) << 8);
            { const bool oddrow = (qg & 1) != 0;
              auto x0_ = __builtin_amdgcn_permlane16_swap(__float_as_uint(bestg), __float_as_uint(bestg), false, false); auto x1_ = __builtin_amdgcn_permlane16_swap(__float_as_uint(s0), __float_as_uint(s0), false, false);
              auto x2_ = __builtin_amdgcn_permlane16_swap(__float_as_uint(s1), __float_as_uint(s1), false, false); auto x3_ = __builtin_amdgcn_permlane16_swap((unsigned)epk, (unsigned)epk, false, false);
              const float og = __uint_as_float(oddrow ? x0_[0] : x0_[1]), o0 = __uint_as_float(oddrow ? x1_[0] : x1_[1]), o1 = __uint_as_float(oddrow ? x2_[0] : x2_[1]); const int oe = (int)(oddrow ? x3_[0] : x3_[1]);
              const bool take = (og > bestg) || (og == bestg && (qg & 1));
              if (take) { bestg = og; s0 = o0; s1 = o1; epk = oe; } }
            { auto r0_ = __builtin_amdgcn_permlane32_swap(__float_as_uint(bestg), __float_as_uint(bestg), false, false);
              auto r1_ = __builtin_amdgcn_permlane32_swap(__float_as_uint(s0), __float_as_uint(s0), false, false);
              auto r2_ = __builtin_amdgcn_permlane32_swap(__float_as_uint(s1), __float_as_uint(s1), false, false);
              auto r3_ = __builtin_amdgcn_permlane32_swap((unsigned)epk, (unsigned)epk, false, false);
              const float gl = __uint_as_float(r0_[0]), gu = __uint_as_float(r0_[1]); const bool up = gu > gl;
              bestg = up ? gu : gl; s0 = __uint_as_float(up ? r1_[1] : r1_[0]); s1 = __uint_as_float(up ? r2_[1] : r2_[0]); epk = (int)(up ? r3_[1] : r3_[0]); }
            const int e0 = epk & 255, e1 = (epk >> 8) & 255;
            if (F.lane == 0) { const float inv = __builtin_amdgcn_rcpf(s0 + s1); toke[row] = e0 | (e1 << 8); tokw[row * 2] = s0 * inv; tokw[row * 2 + 1] = s1 * inv;
                __hip_atomic_fetch_add((LAS unsigned*)(F.MISC + 16 + e0), 1u, __ATOMIC_RELAXED, __HIP_MEMORY_SCOPE_WORKGROUP); __hip_atomic_fetch_add((LAS unsigned*)(F.MISC + 16 + e1), 1u, __ATOMIC_RELAXED, __HIP_MEMORY_SCOPE_WORKGROUP); }
        }
    }
#undef LN1_LDX
    __syncthreads();
    if (F.tid < 16) bcnt[F.vcu * 16 + F.tid] = (int)F.MISC[16 + F.tid];
}

__device__ __forceinline__ void ph_dispatch(Frame F, int Mr) {
    { int t_ = threadIdx.x; asm volatile("" : "+v"(t_)); F.tid = t_; F.lane = t_ & 63; fresh_in(F); }
    const int* bcnt = (const int*)(F.ws + WS_BCNT); const int* toke = (const int*)(F.ws + WS_TOKE); int* tokp = (int*)(F.ws + WS_TOKP); int* meta = (int*)(F.ws + WS_META);
    const bf16* H2 = (const bf16*)(F.ws + WS_HL); bf16* XG = (bf16*)(F.ws + WS_XG);
    LAS int* ip = (LAS int*)F.lds;
    const int per = (F.G + 31) / 32;
    { const int e = F.tid & 15, grp = F.tid >> 4; int sa = 0, sb = 0;
      for (int k = 0; k < per; ++k) { const int blk = grp * per + k; if (blk < F.G) { const int cnt = bcnt[blk * 16 + e]; sa += cnt; if (blk < F.vcu) sb += cnt; } }
      ip[grp * 16 + e] = sa; ip[512 + grp * 16 + e] = sb; }
    __syncthreads();
    if (F.tid < 16) { int sa = 0, sb = 0;
        for (int g = 0; g < 32; ++g) { sa += ip[g * 16 + F.tid]; sb += ip[512 + g * 16 + F.tid]; }
        ip[1024 + F.tid] = sa; ip[1040 + F.tid] = sb; }
    __syncthreads();
    if (F.tid == 0) { int acc = 0;
        for (int e = 0; e < 16; ++e) { ip[1056 + e] = acc; acc += ((ip[1024 + e] + 255) >> 8) << 8; }
        ip[1056 + 16] = acc; }
    __syncthreads();
    if (F.vcu == 0 && F.tid < 17) meta[F.tid] = ip[1056 + F.tid] >> 8;
    const int n0 = F.vcu * NWAVES * F.rpw, n1 = min(n0 + NWAVES * F.rpw, Mr);
    int* rowl = (int*)(F.ws + WS_ROWL);
    if (F.wave == 0) {
        int run[16];
#pragma unroll
        for (int e = 0; e < 16; ++e) run[e] = ip[1056 + e] + ip[1040 + e];
        for (int t0 = n0; t0 < n1; t0 += 64) {
            const int tok = t0 + F.lane; const bool valid = tok < n1; const int ee = valid ? toke[tok] : 0xffff; const int e0 = ee & 255, e1 = (ee >> 8) & 255;
            int p0 = 0, p1 = 0; const unsigned long long lt = (1ull << F.lane) - 1ull;
#pragma unroll
            for (int e = 0; e < 16; ++e) { const unsigned long long m0 = __ballot(valid && e0 == e), m1 = __ballot(valid && e1 == e);
                if (e0 == e) p0 = run[e] + __popcll(m0 & lt);
                if (e1 == e) p1 = run[e] + __popcll(m0) + __popcll(m1 & lt);
                run[e] += __popcll(m0) + __popcll(m1); }
            if (valid) { tokp[tok * 2] = p0; tokp[tok * 2 + 1] = p1; rowl[p0] = tok; rowl[p1] = tok; }
        }
    }
    __syncthreads();
    {
        const int e = F.vcu & 15, part = F.vcu >> 4, nparts = (F.G + 15) >> 4;
        const int pr0 = ip[1056 + e] + ip[1024 + e], pr1 = ip[1056 + e + 1];
        int stride = nparts * NWAVES * 64; asm volatile("" : "+s"(stride));
        for (int p = pr0 + part * (NWAVES * 64) + F.tid; p < pr1; p += stride) rowl[p] = 0;
    }
}

__device__ __forceinline__ void ph_ln2(Frame F, int li, int Mr) {
    { int t_ = threadIdx.x; asm volatile("" : "+v"(t_)); F.tid = t_; F.lane = t_ & 63; fresh_in(F); }
    const float* mod = (const float*)(F.ws + WS_MOD);
    const bf16* Y = (const bf16*)(F.ws + WS_XG); bf16* HL = (bf16*)(F.ws + WS_HL);
    const float* tokw = (const float*)(F.ws + WS_TOKW); const int* tokp = (const int*)(F.ws + WS_TOKP);
    bf16* xb = (bf16*)(F.ws + WS_XB); static_assert(WS_XC == WS_XB + (size_t)LROWS * DM * 2, "context rows follow the latent rows");
    f32x4 lg[4], lb[4]; ld_f32(F.in[15] + li * DM, F.lane, lg); ld_f32(F.in[16] + li * DM, F.lane, lb);
    const int r0 = F.gw * F.rpw, r1 = min(r0 + F.rpw, Mr);
    const bool last = li == DEPTH - 1;
    int bcur = -1; f32x4 g2[4], sc1[4], sh1[4]; u32x2 nv[4], ny0[4], ny1[4];
    if (r0 < r1) { const int q0 = tokp[r0 * 2], q1 = tokp[r0 * 2 + 1];
        { const bf16* xs_ = xb + (size_t)r0 * DM;
#pragma unroll
          for (int j = 0; j < 4; ++j) nv[j] = ((const GAS u32x2*)xs_)[64 * j + F.lane]; }
#pragma unroll
        for (int j = 0; j < 4; ++j) { ny0[j] = ((const GAS u32x2*)(Y + (size_t)q0 * DM))[64 * j + F.lane]; ny1[j] = ((const GAS u32x2*)(Y + (size_t)q1 * DM))[64 * j + F.lane]; } }
    for (int row = r0; row < r1; ++row) {
        const int b = row < LROWS ? row >> 11 : 16;
        if (b != bcur) { bcur = b; const float* mb = mod + ((size_t)li * 17 + b) * 6144; ld_f32(mb + 5120, F.lane, g2);
            if (!last) { const float* mn = mod + ((size_t)(li + 1) * 17 + b) * 6144; ld_f32(mn, F.lane, sh1); ld_f32(mn + 1024, F.lane, sc1);
#pragma unroll
                for (int j = 0; j < 4; ++j) sc1[j] = sc1[j] + 1.0f; } }
        bf16* xp = xb + (size_t)row * DM;
        const float w0 = tokw[row * 2], w1 = tokw[row * 2 + 1];
        f32x4 v[4];
#pragma unroll
        for (int j = 0; j < 4; ++j) { const f32x4 y0 = (f32x4){bflo(ny0[j].x), bfhi(ny0[j].x), bflo(ny0[j].y), bfhi(ny0[j].y)}, y1 = (f32x4){bflo(ny1[j].x), bfhi(ny1[j].x), bflo(ny1[j].y), bfhi(ny1[j].y)};
            v[j] = (f32x4){bflo(nv[j].x), bfhi(nv[j].x), bflo(nv[j].y), bfhi(nv[j].y)} * DN_ALPHA + g2[j] * (y0 * w0 + y1 * w1); }
        if (row + 1 < r1) { const int rn = row + 1; const int q0 = tokp[rn * 2], q1 = tokp[rn * 2 + 1];
            { const bf16* xs_ = xb + (size_t)rn * DM;
#pragma unroll
              for (int j = 0; j < 4; ++j) nv[j] = ((const GAS u32x2*)xs_)[64 * j + F.lane]; }
#pragma unroll
            for (int j = 0; j < 4; ++j) { ny0[j] = ((const GAS u32x2*)(Y + (size_t)q0 * DM))[64 * j + F.lane]; ny1[j] = ((const GAS u32x2*)(Y + (size_t)q1 * DM))[64 * j + F.lane]; } }
        ln_core(v);
#pragma unroll
        for (int j = 0; j < 4; ++j) v[j] = v[j] * lg[j] + lb[j];
        if (last) st_f32(F.out + (size_t)row * DM, F.lane, v); else st_bf16(xp, F.lane, v);
        if (!last) {
#pragma unroll
            for (int j = 0; j < 4; ++j) v[j] = v[j] * sc1[j] + sh1[j];
            st_bf16(HL + (size_t)row * DM, F.lane, v);
        }
    }
}

__global__ void __launch_bounds__(NWAVES * 64, 2) fwd(Args args) {
    extern __shared__ __attribute__((aligned(16))) unsigned char lds[];
    Frame F;
    F.lds = (LAS unsigned char*)lds; F.MISC = (volatile LAS unsigned*)(F.lds + MISC_OFF);
    F.tid = 0; F.lane = 0; F.wave = __builtin_amdgcn_readfirstlane((int)threadIdx.x >> 6);
    F.G = gridDim.x; { const int bx = blockIdx.x; F.vcu = (F.G % 8 == 0) ? (bx % 8) * (F.G / 8) + bx / 8 : bx; }
    F.gw = F.vcu * NWAVES + F.wave; F.NGW = F.G * NWAVES; F.rpw = (MROWS + F.NGW - 1) / F.NGW;
    fresh_in(F); F.out = args.out; F.ws = args.ws;
    for (int u = threadIdx.x; u < (LDS_BYTES - MISC_OFF) / 4; u += NWAVES * 64) F.MISC[u] = 0u;
    __syncthreads();
    XcdBarrier bar; bar.bar = (unsigned*)(args.ws + WS_CTL) + CW_BAR; bar.x = 0; bar.st = nullptr;
    if (!MK_PER_PHASE) bar = xcd_barrier_post((unsigned*)(args.ws + WS_CTL) + CW_BAR, F.MISC);
    const int lo = args.ph_lo, hi = args.ph_hi;
#ifndef PHMASK
#define PHMASK 0xFFFF
#endif
#define PE(n) (((PHMASK) >> (n)) & 1)
#define IN(k) (lo <= (k) && (k) < hi)
#define SEAM(k) do { if (!MK_PER_PHASE && IN(k) && IN((k) + 1)) xcd_barrier(bar); } while (0)

    if (PE(0) && IN(0)) { ph_prologue(F); SEAM(0); }
    if (PE(1) && IN(1)) { ph_hl0(F); SEAM(1); }

    bf16* HL = (bf16*)(args.ws + WS_HL); bf16* QB = (bf16*)(args.ws + WS_Q); bf16* KB = (bf16*)(args.ws + WS_K); bf16* VB = (bf16*)(args.ws + WS_V);
    bf16* AL = (bf16*)(args.ws + WS_AL); bf16* XG = (bf16*)(args.ws + WS_XG);
    const float* rope = (const float*)(args.ws + WS_ROPE);

    for (int li = 0; li < DEPTH; ++li) {
        const int pb = 2 + 8 * li; const bool typeB = (li & 1) != 0, last = li == DEPTH - 1; const int j = li >> 1;
        const int Mr = last ? LROWS : MROWS;
        if (PE(2) && IN(pb + 0)) {
            const bf16* W = typeB ? (const bf16*)(args.ws + WS_WQKVB) + (size_t)j * 3072 * 1024 : (const bf16*)(args.ws + WS_WQKVA) + (size_t)j * 1536 * 1024;
            const int N = typeB ? 3072 : 1536;
            pg8::Gemm g{HL, W, MROWS, N, DM, nullptr, nullptr}; pg8::StaticOrder S; S.init(MROWS, N, F.G, (int)blockIdx.x);
            pg8::EpiQKV E{QB, KB, VB, typeB ? 1024 : 256, typeB ? 4 : 1, rope, QSCALE};
            pg8::gemm_phase<pg8::EpiQKV, pg8::StaticOrder, true, true>(F.lds, g, S, E);
            if (li == 0) {
                const int nu = (MROWS / 256) * (N / 256), c = (int)blockIdx.x, busy = nu % F.G;
                if (busy > 0) { if (c >= busy) convert_experts(F, 0, (c - busy) * NWAVES + F.wave, (F.G - busy) * NWAVES); }
                else convert_experts(F, 0, F.gw, F.NGW);
            }
            SEAM(pb + 0);
        }
        if (IN(pb + 1)) {
            fresh_in(F);
            if (PE(3) && !typeB) {
                const int U = last ? 2048 : 2304;
                att::phase_A((LAS char*)F.lds, QB, KB, VB, QB, F.in[8] + j * 16, F.vcu, F.G, U);
            } else if (PE(4) && typeB) {
                const float lam_init = 0.8f - 0.6f * expf(-0.3f * (float)li);
                const float* lp = F.in[11] + j * 256;
                int ln_ = threadIdx.x; asm volatile("" : "+v"(ln_)); ln_ &= 63;
                const float d1 = wave_sum(lp[ln_] * lp[64 + ln_]), d2 = wave_sum(lp[128 + ln_] * lp[192 + ln_]);
                const float lam = expf(d1) - expf(d2) + lam_init;
                const int U = last ? 2048 : 2304;
                for (int L = F.vcu; L < U; L += F.G) {
                    int pair, qb; if (L < 2048) { pair = L >> 4; qb = L & 15; } else { pair = (L - 2048) >> 1; qb = 16 + ((L - 2048) & 1); }
                    att::unit_B((LAS char*)F.lds, pair >> 3, pair & 7, qb, QB, KB, VB, QB, lam, 1.0f - lam_init, F.in[12] + j * 128);
                }
            }
            SEAM(pb + 1);
        }
        if (PE(5) && IN(pb + 2)) {
            const bf16* W = typeB ? (const bf16*)(args.ws + WS_WOB) + (size_t)j * 1024 * 1024 : (const bf16*)(args.ws + WS_WOA) + (size_t)j * 1024 * 1024;
            pg8::Gemm g{QB, W, Mr, DM, DM, nullptr, nullptr}; pg8::StaticOrder S; S.init(Mr, DM, F.G, (int)blockIdx.x);
            pg8::EpiStore E{AL, DM};
            pg8::gemm_phase<pg8::EpiStore, pg8::StaticOrder, true, true>(F.lds, g, S, E);
            {
                const int nu = (Mr / 256) * 4, c = (int)blockIdx.x, busy = nu - 2 * F.G;
                if (!last && busy > 0 && busy < F.G) { if (c >= busy) convert_experts(F, li + 1, (c - busy) * NWAVES + F.wave, (F.G - busy) * NWAVES); }
                else if (!last) convert_experts(F, li + 1, F.gw, F.NGW);
            }
            SEAM(pb + 2);
        }
        if (PE(6) && IN(pb + 3)) { ph_ln1(F, li, Mr); SEAM(pb + 3); }
        if (PE(7) && IN(pb + 4)) { ph_dispatch(F, Mr); SEAM(pb + 4); }
        if (PE(8) && IN(pb + 5)) {
            const int* meta = (const int*)(args.ws + WS_META);
            { int t_ = threadIdx.x; asm volatile("" : "+v"(t_)); if (t_ < 17) F.MISC[32 + t_] = (unsigned)meta[t_]; }
            __syncthreads();
            pg8::Gemm g{HL, (const bf16*)(args.ws + WS_WGU) + (size_t)li * 16 * 1024 * 1024, 0, 1024, DM, (const int*)(args.ws + WS_ROWL), (LAS int*)(F.lds + ROWTAB_OFF)};
            pg8::GroupedOrder S; S.init((const LAS int*)(F.MISC + 32), F.G, (int)blockIdx.x);
            pg8::EpiGateUp E{AL};
            pg8::gemm_phase<pg8::EpiGateUp, pg8::GroupedOrder, true, true, true>(F.lds, g, S, E);
            if (!last) {
                const int nu = (int)F.MISC[32 + 16] * 4, c = (int)blockIdx.x, busy = nu % F.G;
                const int w_ = busy > 0 ? c - busy : c, nw_ = busy > 0 ? F.G - busy : F.G;
                if (w_ >= 0) adaln_gemv<16>(F, 48 * (li + 1), 48 * (li + 2), w_, nw_);
            }
            SEAM(pb + 5);
        }
        if (PE(9) && IN(pb + 6)) {
            const int* meta = (const int*)(args.ws + WS_META);
            { int t_ = threadIdx.x; asm volatile("" : "+v"(t_)); if (t_ < 17) F.MISC[32 + t_] = (unsigned)meta[t_]; }
            __syncthreads();
            pg8::Gemm g{AL, (const bf16*)(args.ws + WS_WDN) + (size_t)li * 16 * 1024 * 512, 0, 1024, 512, nullptr, nullptr};
            pg8::GroupedOrder S; S.init((const LAS int*)(F.MISC + 32), F.G, (int)blockIdx.x);
            pg8::EpiStore E{XG, DM};
            pg8::gemm_phase<pg8::EpiStore, pg8::GroupedOrder, true, true>(F.lds, g, S, E);
            SEAM(pb + 6);
        }
        if (PE(10) && IN(pb + 7)) { ph_ln2(F, li, Mr); SEAM(pb + 7); }
    }
#undef IN
#undef SEAM
}

extern "C" void kernel_launch(void* const* d_in, const int* in_sizes, int n_in, void* d_out, int out_size, void* d_ws, size_t ws_size, hipStream_t stream) {
    static int grid = 0;
    if (grid == 0) {
        if (n_in != 22 || out_size != LROWS * DM || ws_size < WS_END) { fprintf(stderr, "kernel_launch: unexpected shapes (n_in %d, out %d, ws %zu < %zu); nothing launched\n", n_in, out_size, ws_size, (size_t)WS_END); grid = -1; return; }
        int dev = 0, cus = 0, per_cu = 0;
        if (hipGetDevice(&dev) != hipSuccess || hipDeviceGetAttribute(&cus, hipDeviceAttributeMultiprocessorCount, dev) != hipSuccess) { grid = -1; return; }
        if (hipFuncSetAttribute((const void*)fwd, hipFuncAttributeMaxDynamicSharedMemorySize, LDS_BYTES) != hipSuccess) { fprintf(stderr, "kernel_launch: hipFuncSetAttribute failed\n"); grid = -1; return; }
        if (hipOccupancyMaxActiveBlocksPerMultiprocessor(&per_cu, (const void*)fwd, NWAVES * 64, LDS_BYTES) != hipSuccess || per_cu < 1) { fprintf(stderr, "kernel_launch: occupancy query reports %d\n", per_cu); }
        (void)hipGetLastError();
        grid = cus;
    }
    if (grid < 0) return;
    (void)hipMemsetAsync((char*)d_ws + WS_CTL, 0, CTL_ZERO_BYTES, stream);
    Args a{};
    for (int i = 0; i < 22; ++i) a.in[i] = (const float*)d_in[i];
    a.out = (float*)d_out; a.ws = (unsigned char*)d_ws;
#if MK_PER_PHASE
    for (int p = 0; p < NPHASE; ++p) { a.ph_lo = p; a.ph_hi = p + 1; hipLaunchKernelGGL(fwd, dim3(grid), dim3(NWAVES * 64), LDS_BYTES, stream, a); }
#else
    a.ph_lo = 0; a.ph_hi = NPHASE; hipLaunchKernelGGL(fwd, dim3(grid), dim3(NWAVES * 64), LDS_BYTES, stream, a);
#endif
}
```

```cpp
#include <hip/hip_runtime.h>
#include <cstdio>
#include <cstdint>

namespace pg8 {
#define PG8_LAS __attribute__((address_space(3)))
typedef unsigned short bf16_t;
typedef short bf16x8 __attribute__((ext_vector_type(8)));
typedef float f32x4 __attribute__((ext_vector_type(4)));
typedef unsigned u32x4 __attribute__((ext_vector_type(4)));
typedef unsigned u32x2 __attribute__((ext_vector_type(2)));
constexpr int BM = 256, BK = 64, HALF = 128, HTB = HALF * BK * 2  , STAGE_BYTES = 8 * HTB, NXCD = 8, WGM = 8;

__host__ __device__ __forceinline__ int lds_byte(int r, int c) { const int st = (r >> 4) * 2 + (c >> 5), rr = r & 15, cc = c & 31, ob = rr * 64 + cc * 2; return st * 1024 + (ob ^ (((ob >> 9) & 1) << 5)); }
__host__ __device__ __forceinline__ void stage_rc(int b, int& R, int& C) { const int st = b / 1024, sb = b % 1024, swz = sb ^ (((sb >> 9) & 1) << 5); R = (st >> 1) * 16 + swz / 64; C = (st & 1) * 32 + (swz % 64) / 2; }
__host__ __device__ __forceinline__ int perm32(int rho) { const int n = rho >> 4, i = rho & 15; return 8 * (i >> 2) + 4 * n + (i & 3); }

struct Unit { int pm, pn, pb; };
struct Gemm { const bf16_t* A; const bf16_t* Bt; int M, N, K; const int* rowlist; PG8_LAS int* rowtab; };

struct StaticOrder {
    int nM, nN, nwg, G, c;
    __host__ __device__ void init(int M, int N, int G_, int c_) { nM = M / BM; nN = N / BM; nwg = nM * nN; G = G_; c = c_; }
    __host__ __device__ bool next(int i, Unit& u) const {
        const long L = (long)i * G + c; if (L >= nwg) return false;
        int wgid = (int)L; { const int q = nwg / NXCD, r = nwg % NXCD, xcd = wgid % NXCD, off = wgid / NXCD; wgid = (xcd < r ? xcd * (q + 1) : r * (q + 1) + (xcd - r) * q) + off; }
        const int nig = WGM * nN, gid = wgid / nig, fm = gid * WGM, gsz = (nM - fm) < WGM ? (nM - fm) : WGM;
        u.pm = fm + ((wgid % nig) % gsz); u.pn = (wgid % nig) / gsz; u.pb = u.pn; return true;
    }
    __device__ __forceinline__ void a_ready(const Unit&) const {}
    __device__ __forceinline__ void done(const Unit&) const {}
};
struct GroupedOrder {
    const PG8_LAS int* tb; int nwg, G, c;
    __device__ __forceinline__ void init(const PG8_LAS int* tb_, int G_, int c_) { tb = tb_; nwg = tb_[16] * 4; G = G_; c = c_; }
    __device__ __forceinline__ bool next(int i, Unit& u) const {
        const long L = (long)i * G + c; if (L >= nwg) return false;
        int wgid = (int)L; { const int q = nwg / NXCD, r = nwg % NXCD, xcd = wgid % NXCD, off = wgid / NXCD; wgid = (xcd < r ? xcd * (q + 1) : r * (q + 1) + (xcd - r) * q) + off; }
        u.pm = wgid >> 2; u.pn = wgid & 3; int e = 0;
#pragma unroll
        for (int j = 1; j < 16; ++j) e += (tb[j] <= u.pm) ? 1 : 0;
        u.pb = e * 4 + u.pn; return true;
    }
    __device__ __forceinline__ void a_ready(const Unit&) const {}
    __device__ __forceinline__ void done(const Unit&) const {}
};

__device__ __forceinline__ unsigned cvt_pk_bf16(float lo, float hi) { unsigned r; asm volatile("v_cvt_pk_bf16_f32 %0, %1, %2" : "=v"(r) : "v"(lo), "v"(hi)); return r; }

struct EpiStore {
    static constexpr bool PERM = true, AFTER_DRAIN = false;
    bf16_t* O; int ldc;
    __device__ __forceinline__ void operator()(const f32x4 (&acc)[2][2][4][2], const Unit& u, int wr, int wc, int fr, int fq) const {
        const int row0 = u.pm * BM + wr * 64 + fr, col0 = u.pn * BM + wc * 32 + 8 * fq;
#pragma unroll
        for (int ai = 0; ai < 2; ++ai)
#pragma unroll
            for (int m = 0; m < 4; ++m) { bf16_t* rowp = O + (size_t)(row0 + ai * HALF + m * 16) * ldc + col0;
#pragma unroll
                for (int bj = 0; bj < 2; ++bj) { const f32x4 v0 = acc[ai][bj][m][0], v1 = acc[ai][bj][m][1];
                    u32x4 w; w.x = cvt_pk_bf16(v0[0], v0[1]); w.y = cvt_pk_bf16(v0[2], v0[3]); w.z = cvt_pk_bf16(v1[0], v1[1]); w.w = cvt_pk_bf16(v1[2], v1[3]);
                    *(u32x4*)(rowp + bj * HALF) = w; } }
    }
};
struct EpiGateUp {
    static constexpr bool PERM = true, AFTER_DRAIN = false;
    bf16_t* O;
    __device__ __forceinline__ void operator()(const f32x4 (&acc)[2][2][4][2], const Unit& u, int wr, int wc, int fr, int fq) const {
        const int row0 = u.pm * BM + wr * 64 + fr, col0 = (u.pn * BM + wc * 32 + 8 * fq) >> 1;
#pragma unroll
        for (int ai = 0; ai < 2; ++ai)
#pragma unroll
            for (int m = 0; m < 4; ++m) { bf16_t* rowp = O + (size_t)(row0 + ai * HALF + m * 16) * 512 + col0;
#pragma unroll
                for (int bj = 0; bj < 2; ++bj) { const f32x4 g = acc[ai][bj][m][0], up = acc[ai][bj][m][1]; f32x4 a;
#pragma unroll
                    for (int e = 0; e < 4; ++e) { const float sg = __builtin_amdgcn_rcpf(1.0f + __builtin_amdgcn_exp2f(-1.4426950408889634f * g[e])); a[e] = g[e] * sg * up[e]; }
                    u32x2 w; w.x = cvt_pk_bf16(a[0], a[1]); w.y = cvt_pk_bf16(a[2], a[3]);
                    *(u32x2*)(rowp + bj * (HALF / 2)) = w; } }
    }
};
struct EpiQKV {
    static constexpr bool PERM = true, AFTER_DRAIN = false;
    bf16_t *Q, *K, *V; int kvp, nk; const float* rope; float qscale;
    __device__ __forceinline__ void operator()(const f32x4 (&acc)[2][2][4][2], const Unit& u, int wr, int wc, int fr, int fq) const {
        bf16_t* base; int ldc, colt; bool rp; float sc;
        if (u.pn < 4) { base = Q; ldc = 1024; colt = u.pn * BM; rp = true; sc = qscale; }
        else if (u.pn < 4 + nk) { base = K; ldc = kvp; colt = (u.pn - 4) * BM; rp = true; sc = 1.0f; }
        else { base = V; ldc = kvp; colt = (u.pn - 4 - nk) * BM; rp = false; sc = 1.0f; }
        rp = rp && (u.pm < 128);
        const int row0 = u.pm * BM + wr * 64 + fr, col0 = colt + wc * 32 + 8 * fq;
        const int pi0 = (col0 & 63) >> 1; const bool rowax = (wc & 1) == 0;
        f32x4 t0[4], t1[4];
#pragma unroll
        for (int i = 0; i < 4; ++i) { t0[i] = (f32x4){1.f, 0.f, 1.f, 0.f}; t1[i] = t0[i]; }
        if (rp) {
            if (rowax) {
#pragma unroll
                for (int ai = 0; ai < 2; ++ai) { const int pos = ((u.pm * BM + ai * HALF + wr * 64) & 2047) & ~63; const float* tp = rope + ((size_t)pos * 32 + pi0) * 2; t0[ai] = *(const f32x4*)tp; t1[ai] = *(const f32x4*)(tp + 4); }
            } else {
#pragma unroll
                for (int m = 0; m < 4; ++m) { const int pos = m * 16 + fr; const float* tp = rope + ((size_t)pos * 32 + pi0) * 2; t0[m] = *(const f32x4*)tp; t1[m] = *(const f32x4*)(tp + 4); }
            }
        }
#pragma unroll
        for (int ai = 0; ai < 2; ++ai)
#pragma unroll
            for (int m = 0; m < 4; ++m) { const int row = row0 + ai * HALF + m * 16; bf16_t* rowp = base + (size_t)row * ldc + col0;
                const f32x4 c0 = rowax ? t0[ai] : t0[m], c1 = rowax ? t1[ai] : t1[m];
#pragma unroll
                for (int bj = 0; bj < 2; ++bj) { f32x4 v0 = acc[ai][bj][m][0], v1 = acc[ai][bj][m][1];
                    if (rp) { f32x4 a, b;
                        a[0] = v0[0] * c0[0] - v0[1] * c0[1]; a[1] = v0[1] * c0[0] + v0[0] * c0[1]; a[2] = v0[2] * c0[2] - v0[3] * c0[3]; a[3] = v0[3] * c0[2] + v0[2] * c0[3];
                        b[0] = v1[0] * c1[0] - v1[1] * c1[1]; b[1] = v1[1] * c1[0] + v1[0] * c1[1]; b[2] = v1[2] * c1[2] - v1[3] * c1[3]; b[3] = v1[3] * c1[2] + v1[2] * c1[3];
                        v0 = a; v1 = b; }
                    v0 = v0 * sc; v1 = v1 * sc;
                    u32x4 w; w.x = cvt_pk_bf16(v0[0], v0[1]); w.y = cvt_pk_bf16(v0[2], v0[3]); w.z = cvt_pk_bf16(v1[0], v1[1]); w.w = cvt_pk_bf16(v1[2], v1[3]);
                    *(u32x4*)(rowp + bj * HALF) = w; } }
    }
};

template <class Epi, class Sched, bool ALIGN_EPI = false, bool SP2 = false, bool GATHER = false>
__device__ __forceinline__ void gemm_phase(PG8_LAS unsigned char* lds, const Gemm g, const Sched& S, const Epi& E) {
    int tid_ = threadIdx.x; asm volatile("" : "+v"(tid_));
    const int tid = tid_, wid = __builtin_amdgcn_readfirstlane(tid >> 6), lane = tid & 63, wr = wid >> 2, wc = wid & 3, fr = lane & 15, fq = lane >> 4;
    const int K = g.K, nt = K / BK;
    unsigned voffA[2], voffB[2];
#pragma unroll
    for (int i = 0; i < 2; ++i) { int R, C; stage_rc(tid * 16 + i * 8192, R, C); const int Rb = Epi::PERM ? ((R & ~31) + perm32(R & 31)) : R;
        voffA[i] = (unsigned)(R * K + C) * 2u; voffB[i] = (unsigned)(Rb * K + C) * 2u; }
    unsigned vc[2] = {0u, 0u}, vn[2] = {0u, 0u}, cofs[2] = {0u, 0u}; const size_t rowb = (size_t)K * 2;
    if constexpr (GATHER) {
#pragma unroll
        for (int i = 0; i < 2; ++i) { int R, C; stage_rc(tid * 16 + i * 8192, R, C); cofs[i] = (unsigned)C * 2u; }
        Unit u_;
        for (int i = 0; S.next(i, u_); ++i) if (tid < 256) g.rowtab[i * 256 + tid] = g.rowlist[u_.pm * 256 + tid];
        asm volatile("s_waitcnt vmcnt(0) lgkmcnt(0)" ::: "memory"); __builtin_amdgcn_s_barrier(); asm volatile("" ::: "memory");
    }
#define PG8_LDROWS(slot, dst) do { int R0_, C0_, R1_, C1_; stage_rc(tid * 16, R0_, C0_); stage_rc(tid * 16 + 8192, R1_, C1_); \
        _Pragma("unroll") for (int h_ = 0; h_ < 2; ++h_) dst[h_] = (unsigned)g.rowtab[(slot) * 256 + h_ * 128 + R0_] | ((unsigned)g.rowtab[(slot) * 256 + h_ * 128 + R1_] << 16); } while (0)
    const size_t kstep = (size_t)(BK * 2);
    const size_t hstep = (size_t)HALF * K * 2;
    const size_t tstep = 2 * hstep;
    const unsigned ldsw = (unsigned)wid * 1024u;
    const int aoff = lds_byte(wr * 64 + fr, fq * 8), boff = lds_byte(wc * 32 + fr, fq * 8);
#define PG8_SA(b, h) (((b) * 2 + (h)) * HTB)
#define PG8_SB(b, h) ((4 + (b) * 2 + (h)) * HTB)
#define PG8_STAGE(bufoff, gbase, voff) do { _Pragma("unroll") for (int _i = 0; _i < 2; ++_i) \
        __builtin_amdgcn_global_load_lds((const unsigned*)((const char*)(gbase) + (voff)[_i]), (PG8_LAS unsigned*)(lds + (bufoff) + ldsw + _i * 8192), 16, 0, 0); } while (0)
#define PG8_STAGE_A(bufoff, abase, h, NX) do { if constexpr (GATHER) { const unsigned rp_ = (NX) ? vn[h] : vc[h]; \
        _Pragma("unroll") for (int _i = 0; _i < 2; ++_i) { const unsigned row_ = _i ? (rp_ >> 16) : (rp_ & 0xffffu); \
            __builtin_amdgcn_global_load_lds((const unsigned*)((const char*)(abase) + (size_t)row_ * rowb + cofs[_i]), (PG8_LAS unsigned*)(lds + (bufoff) + ldsw + _i * 8192), 16, 0, 0); } } \
    else { PG8_STAGE(bufoff, (abase) + ((h) ? hstep : (size_t)0), voffA); } } while (0)
#define PG8_LDA(dst, b, h) do { _Pragma("unroll") for (int m = 0; m < 4; ++m) _Pragma("unroll") for (int k = 0; k < 2; ++k) dst[m][k] = *(const PG8_LAS bf16x8*)(lds + PG8_SA(b, h) + aoff + m * 2048 + k * 1024); } while (0)
#define PG8_LDB(dst, b, h) do { _Pragma("unroll") for (int n = 0; n < 2; ++n) _Pragma("unroll") for (int k = 0; k < 2; ++k) dst[n][k] = *(const PG8_LAS bf16x8*)(lds + PG8_SB(b, h) + boff + n * 2048 + k * 1024); } while (0)
#define PG8_MMA(ai, bj, At, Bt) do { __builtin_amdgcn_s_setprio(1); _Pragma("unroll") for (int m = 0; m < 4; ++m) _Pragma("unroll") for (int n = 0; n < 2; ++n) _Pragma("unroll") for (int k = 0; k < 2; ++k) \
        acc[ai][bj][m][n] = __builtin_amdgcn_mfma_f32_16x16x32_bf16(Bt[n][k], At[m][k], acc[ai][bj][m][n], 0, 0, 0); __builtin_amdgcn_s_setprio(0); } while (0)
#define PG8_WAIT_V(n) asm volatile("s_waitcnt vmcnt(" #n ")" ::: "memory")
#define PG8_WAIT_L(n) asm volatile("s_waitcnt lgkmcnt(" #n ")" ::: "memory")
#define PG8_BAR __builtin_amdgcn_s_barrier()
#define PG8_SCHED __builtin_amdgcn_sched_barrier(0)
    Unit cur, nxt; int ui = 0;
    if (!S.next(0, cur)) return;
    f32x4 acc[2][2][4][2];
#pragma unroll
    for (int a = 0; a < 2; ++a)
#pragma unroll
        for (int b = 0; b < 2; ++b)
#pragma unroll
            for (int m = 0; m < 4; ++m)
#pragma unroll
                for (int n = 0; n < 2; ++n) acc[a][b][m][n] = (f32x4){0.f, 0.f, 0.f, 0.f};
    bf16x8 At[4][2], B0[2][2], B1[2][2];
    const char* cA = (const char*)g.A + (GATHER ? (size_t)0 : (size_t)cur.pm * tstep); const char* cB = (const char*)g.Bt + (size_t)cur.pb * tstep;
    if constexpr (GATHER) { PG8_LDROWS(0, vc); }
    S.a_ready(cur);
    if constexpr (SP2) {
        PG8_STAGE(PG8_SB(0, 0), cB, voffB); PG8_STAGE(PG8_SB(0, 1), cB + hstep, voffB); PG8_STAGE_A(PG8_SA(0, 0), cA, 0, false); PG8_STAGE_A(PG8_SA(0, 1), cA, 1, false);
        if (wr == 1) PG8_BAR;
        PG8_WAIT_V(2); PG8_BAR;
        PG8_STAGE(PG8_SB(1, 0), cB + kstep, voffB); PG8_STAGE_A(PG8_SA(1, 0), cA + kstep, 0, false); PG8_STAGE(PG8_SB(1, 1), cB + hstep + kstep, voffB);
        PG8_WAIT_V(6); PG8_BAR;
    } else {
        PG8_STAGE(PG8_SB(0, 0), cB, voffB); PG8_STAGE_A(PG8_SA(0, 0), cA, 0, false); PG8_STAGE(PG8_SB(0, 1), cB + hstep, voffB); PG8_STAGE_A(PG8_SA(0, 1), cA, 1, false);
        if (wr == 1) PG8_BAR;
        PG8_WAIT_V(4); PG8_BAR;
        PG8_STAGE(PG8_SB(1, 0), cB + kstep, voffB); PG8_STAGE_A(PG8_SA(1, 0), cA + kstep, 0, false); PG8_STAGE(PG8_SB(1, 1), cB + hstep + kstep, voffB);
        PG8_WAIT_V(6); PG8_BAR;
    }
    for (;;) {
        const bool has_next = S.next(ui + 1, nxt);
        const char* nA = (has_next && !GATHER) ? (const char*)g.A + (size_t)nxt.pm * tstep : cA;
        if constexpr (GATHER) { if (has_next) { PG8_LDROWS(ui + 1, vn); } else { vn[0] = vc[0]; vn[1] = vc[1]; } } const char* nB = has_next ? (const char*)g.Bt + (size_t)nxt.pb * tstep : cB;
        for (int t = 0; t < nt; t += 2) {
            const bool last = (t == nt - 2);
            const char* a1 = cA + (size_t)(t + 1) * kstep;
            const char* a2 = last ? nA : cA + (size_t)(t + 2) * kstep; const char* b2 = last ? nB : cB + (size_t)(t + 2) * kstep;
            const char* a3 = a2 + kstep; const char* b3 = b2 + kstep;
            if (last && has_next) S.a_ready(nxt);
            if constexpr (SP2) {
            PG8_LDB(B0, 0, 0); PG8_LDB(B1, 0, 1); PG8_SCHED; PG8_LDA(At, 0, 0); PG8_STAGE_A(PG8_SA(1, 1), a1, 1, false);
            PG8_WAIT_V(8); PG8_WAIT_L(0); PG8_BAR; PG8_MMA(0, 0, At, B0); PG8_MMA(0, 1, At, B1); PG8_BAR; PG8_SCHED;
            PG8_LDA(At, 0, 1); PG8_STAGE(PG8_SB(0, 0), b2, voffB); PG8_STAGE(PG8_SB(0, 1), b2 + hstep, voffB); PG8_STAGE_A(PG8_SA(0, 0), a2, 0, last);
            PG8_WAIT_V(8); PG8_WAIT_L(0); PG8_BAR; PG8_MMA(1, 0, At, B0); PG8_MMA(1, 1, At, B1); PG8_BAR; PG8_SCHED;
            PG8_LDB(B0, 1, 0); PG8_LDB(B1, 1, 1); PG8_SCHED; PG8_LDA(At, 1, 0); PG8_STAGE_A(PG8_SA(0, 1), a2, 1, last);
            PG8_WAIT_V(8); PG8_WAIT_L(0); PG8_BAR; PG8_MMA(0, 0, At, B0); PG8_MMA(0, 1, At, B1); PG8_BAR; PG8_SCHED;
            PG8_LDA(At, 1, 1); PG8_STAGE(PG8_SB(1, 0), b3, voffB); PG8_STAGE(PG8_SB(1, 1), b3 + hstep, voffB); PG8_STAGE_A(PG8_SA(1, 0), a3, 0, last);
            PG8_WAIT_V(8); PG8_WAIT_L(0); PG8_BAR; PG8_MMA(1, 0, At, B0); PG8_MMA(1, 1, At, B1); PG8_BAR; PG8_SCHED;
            } else {
            PG8_LDB(B0, 0, 0); PG8_SCHED; PG8_LDA(At, 0, 0); PG8_STAGE_A(PG8_SA(1, 1), a1, 1, false);
            PG8_WAIT_L(8); PG8_BAR; PG8_WAIT_L(0); PG8_MMA(0, 0, At, B0); PG8_BAR; PG8_SCHED;
            PG8_LDB(B1, 0, 1); PG8_STAGE(PG8_SB(0, 0), b2, voffB);
            PG8_BAR; PG8_WAIT_L(0); PG8_MMA(0, 1, At, B1); PG8_BAR;
            PG8_LDA(At, 0, 1); PG8_STAGE_A(PG8_SA(0, 0), a2, 0, last);
            PG8_BAR; PG8_WAIT_L(0); PG8_MMA(1, 0, At, B0); PG8_BAR; PG8_SCHED;
            PG8_STAGE(PG8_SB(0, 1), b2 + hstep, voffB);
            PG8_WAIT_V(6); PG8_BAR; PG8_MMA(1, 1, At, B1); PG8_BAR;
            PG8_LDB(B0, 1, 0); PG8_SCHED; PG8_LDA(At, 1, 0); PG8_STAGE_A(PG8_SA(0, 1), a2, 1, last);
            PG8_WAIT_L(8); PG8_BAR; PG8_WAIT_L(0); PG8_MMA(0, 0, At, B0); PG8_BAR; PG8_SCHED;
            PG8_LDB(B1, 1, 1); PG8_STAGE(PG8_SB(1, 0), b3, voffB);
            PG8_BAR; PG8_WAIT_L(0); PG8_MMA(0, 1, At, B1); PG8_BAR;
            PG8_LDA(At, 1, 1); PG8_STAGE_A(PG8_SA(1, 0), a3, 0, last);
            PG8_BAR; PG8_WAIT_L(0); PG8_MMA(1, 0, At, B0); PG8_BAR; PG8_SCHED;
            PG8_STAGE(PG8_SB(1, 1), b3 + hstep, voffB);
            PG8_WAIT_V(6); PG8_BAR; PG8_MMA(1, 1, At, B1); PG8_BAR;
            }
        }
        if constexpr (ALIGN_EPI) { if (wr == 0) PG8_BAR; }
        if constexpr (!Epi::AFTER_DRAIN) { E(acc, cur, wr, wc, fr, fq); S.done(cur); }
        if (!has_next) break;
#pragma unroll
        for (int a = 0; a < 2; ++a)
#pragma unroll
            for (int b = 0; b < 2; ++b)
#pragma unroll
                for (int m = 0; m < 4; ++m)
#pragma unroll
                    for (int n = 0; n < 2; ++n) acc[a][b][m][n] = (f32x4){0.f, 0.f, 0.f, 0.f};
        cur = nxt; cA = nA; cB = nB; ++ui; if constexpr (GATHER) { vc[0] = vn[0]; vc[1] = vn[1]; }
        if constexpr (ALIGN_EPI) { if (wr == 1) PG8_BAR; }
    }
    PG8_WAIT_V(0);
    if constexpr (!ALIGN_EPI) { if (wr == 0) PG8_BAR; }
    PG8_BAR;
    if constexpr (Epi::AFTER_DRAIN) { E.fused(acc, cur, wr, wc, fr, fq, lds, wid, lane); S.done(cur); }
#undef PG8_SA
#undef PG8_SB
#undef PG8_STAGE
#undef PG8_STAGE_A
#undef PG8_LDROWS
#undef PG8_LDA
#undef PG8_LDB
#undef PG8_MMA
#undef PG8_WAIT_V
#undef PG8_WAIT_L
#undef PG8_BAR
#undef PG8_SCHED
}}

namespace att {
#define ALAS __attribute__((address_space(3)))
typedef unsigned short bf16_t;
typedef short bf16x8 __attribute__((ext_vector_type(8)));
typedef short s16x4 __attribute__((ext_vector_type(4)));
typedef float f32x16 __attribute__((ext_vector_type(16)));
typedef unsigned u32x4 __attribute__((ext_vector_type(4)));
typedef float f32x2_t __attribute__((ext_vector_type(2))); typedef __bf16 bf16x2_t __attribute__((ext_vector_type(2)));
constexpr float THR = 8.0f;
constexpr int LROWS = 32768;
__device__ __forceinline__ int crow(int r, int hi) { return (r & 3) + 8 * (r >> 2) + 4 * hi; }
__device__ __forceinline__ unsigned cvtpk(float lo, float hi) { f32x2_t v = {lo, hi}; bf16x2_t b = __builtin_convertvector(v, bf16x2_t); return __builtin_bit_cast(unsigned, b); }
__device__ __forceinline__ unsigned short f2bf(float f) { unsigned u = __builtin_bit_cast(unsigned, f); return (unsigned short)((u + 0x7fffu + ((u >> 16) & 1u)) >> 16); }
typedef short v4i16_t __attribute__((ext_vector_type(4)));
__device__ __forceinline__ s16x4 vtr(const ALAS char* p) { return __builtin_bit_cast(s16x4, __builtin_amdgcn_ds_read_tr16_b64_v4i16((ALAS v4i16_t*)p)); }
template <int X> __device__ __forceinline__ float lane_xor32(float v) {
    if (X == 1) return __builtin_bit_cast(float, __builtin_amdgcn_update_dpp(0, __builtin_bit_cast(int, v), 0xB1, 0xF, 0xF, true));
    if (X == 2) return __builtin_bit_cast(float, __builtin_amdgcn_update_dpp(0, __builtin_bit_cast(int, v), 0x4E, 0xF, 0xF, true));
    return __builtin_bit_cast(float, __builtin_amdgcn_ds_swizzle(__builtin_bit_cast(int, v), (X << 10) | 0x1F));
}
__device__ __forceinline__ float half_sum32(float v) { v += lane_xor32<1>(v); v += lane_xor32<2>(v); v += lane_xor32<4>(v); v += lane_xor32<8>(v); v += lane_xor32<16>(v); return v; }
__device__ __forceinline__ float swapmax(float m) { auto rr = __builtin_amdgcn_permlane32_swap(__float_as_uint(m), __float_as_uint(m), false, false); return fmaxf(__uint_as_float(rr[0]), __uint_as_float(rr[1])); }
__device__ __forceinline__ float swapadd(float m) { auto rr = __builtin_amdgcn_permlane32_swap(__float_as_uint(m), __float_as_uint(m), false, false); return __uint_as_float(rr[0]) + __uint_as_float(rr[1]); }

__device__ __forceinline__ void glds16(const void* gsrc, unsigned lds_dst) {
    asm volatile("s_mov_b32 m0, %1\n\ts_nop 0\n\tglobal_load_lds_dwordx4 %0, off" :: "v"(gsrc), "s"(lds_dst) : "memory", "m0"); }
#define RFL(x) ((unsigned)__builtin_amdgcn_readfirstlane((int)(x)))
struct DmaA { const bf16_t* k; const bf16_t* v; unsigned sb; bool on;
    __device__ __forceinline__ void operator()(int i) const { if (on) { if (i == 0) glds16(k, RFL(sb)); if (i == 2) glds16(v, RFL(sb + 8192)); } } };
struct DmaB { const bf16_t* k; const bf16_t* v; unsigned sb; bool on;
    __device__ __forceinline__ void operator()(int i) const { if (on) { if (i == 0) glds16(k, RFL(sb)); if (i == 1) glds16(k + 64, RFL(sb + 8192)); if (i == 2) glds16(v, RFL(sb + 16384)); if (i == 3) glds16(v + 64, RFL(sb + 24576)); } } };
template <int DVB, class DMA>
__device__ __forceinline__ void step_y(const DMA& dma, const ALAS char* Vs, f32x16 (&o)[DVB], const u32x4 (&pw)[4], int lane, int hi) {
    const ALAS char* vp = Vs + ((lane >> 4) & 1) * 32 + (lane & 3) * 8 + (4 * hi + ((lane & 15) >> 2)) * 64;
    s16x4 va[8], vb[8];
#pragma unroll
    for (int ks = 0; ks < 4; ++ks) { va[2 * ks] = vtr(vp + ks * 1024); va[2 * ks + 1] = vtr(vp + ks * 1024 + 512); }
#pragma unroll
    for (int db = 0; db < DVB; ++db) {
        if (db + 1 < DVB) {
#pragma unroll
            for (int ks = 0; ks < 4; ++ks) { vb[2 * ks] = vtr(vp + (db + 1) * 4096 + ks * 1024); vb[2 * ks + 1] = vtr(vp + (db + 1) * 4096 + ks * 1024 + 512); }
        }
        __builtin_amdgcn_sched_barrier(0);
        __builtin_amdgcn_s_setprio(1);
#pragma unroll
        for (int ks = 0; ks < 4; ++ks) {
            const bf16x8 vf = (bf16x8){va[2 * ks][0], va[2 * ks][1], va[2 * ks][2], va[2 * ks][3], va[2 * ks + 1][0], va[2 * ks + 1][1], va[2 * ks + 1][2], va[2 * ks + 1][3]};
            o[db] = __builtin_amdgcn_mfma_f32_32x32x16_bf16(__builtin_bit_cast(bf16x8, pw[ks]), vf, o[db], 0, 0, 0);
        }
        __builtin_amdgcn_s_setprio(0);
        dma(DVB == 2 ? 2 * db : db);
        __builtin_amdgcn_sched_barrier(0);
        if (db + 1 < DVB) {
#pragma unroll
            for (int i = 0; i < 8; ++i) va[i] = vb[i];
        }
    }
}
template <bool MASK, bool PREV, class DMA, bool CHECK = true>
__device__ __forceinline__ bool step_qk(const DMA& dma, const ALAS char* Ks, const ALAS char* Vs, s16x4 (&vlo)[4], s16x4 (&vhi)[4], const bf16x8 (&qr)[4], f32x16& p0, f32x16& p1, f32x16& negm, float& mhat, float& l, ALAS float* wsf, int lane, int r32, int hi, bool first, int mrel) {
    const ALAS char* kb = Ks + r32 * 128; const int sw = (r32 >> 1) & 7;
    bf16x8 kc0[4], kc1[4];
    { const int off = ((0 + hi) ^ sw) << 4; kc0[0] = *(const ALAS bf16x8*)(kb + off); kc1[0] = *(const ALAS bf16x8*)(kb + 4096 + off); }
#pragma unroll
    for (int d0 = 0; d0 < 4; ++d0) {
        if (d0 + 1 < 4) { const int off = ((2 * (d0 + 1) + hi) ^ sw) << 4; kc0[d0 + 1] = *(const ALAS bf16x8*)(kb + off); kc1[d0 + 1] = *(const ALAS bf16x8*)(kb + 4096 + off); }
        __builtin_amdgcn_sched_barrier(0);
        if (d0 == 0) { p0 = __builtin_amdgcn_mfma_f32_32x32x16_bf16(kc0[0], qr[0], negm, 0, 0, 0);
            asm volatile("v_mfma_f32_32x32x16_bf16 %0, %1, %2, %3" : "=&v"(p1) : "v"(kc1[0]), "v"(qr[0]), "v"(negm)); }
        else { p0 = __builtin_amdgcn_mfma_f32_32x32x16_bf16(kc0[d0], qr[d0], p0, 0, 0, 0); p1 = __builtin_amdgcn_mfma_f32_32x32x16_bf16(kc1[d0], qr[d0], p1, 0, 0, 0); }
        dma(d0);
    }
    if (PREV) {
        const ALAS char* vp = Vs + ((lane >> 4) & 1) * 32 + (lane & 3) * 8 + (4 * hi + ((lane & 15) >> 2)) * 64;
#pragma unroll
        for (int i = 0; i < 4; ++i) { vlo[i] = vtr(vp + i * 1024); vhi[i] = vtr(vp + i * 1024 + 512); }
    }
    if (MASK) {
#pragma unroll
        for (int r = 0; r < 16; ++r) { const int rel = mrel + crow(r, hi);
            if (rel < -128 || rel > 128) p0[r] = -INFINITY;
            if (rel + 32 < -128 || rel + 32 > 128) p1[r] = -INFINITY; }
    }
    if (!CHECK) return false;
    float ma = fmaxf(fmaxf(p0[0], p0[1]), p1[0]), mb = fmaxf(fmaxf(p0[2], p0[3]), p1[1]);
    ma = fmaxf(fmaxf(ma, p1[2]), p1[3]);
#pragma unroll
    for (int r = 4; r < 16; r += 4) { ma = fmaxf(fmaxf(ma, p0[r]), p0[r + 1]); mb = fmaxf(fmaxf(mb, p0[r + 2]), p0[r + 3]); ma = fmaxf(fmaxf(ma, p1[r]), p1[r + 1]); mb = fmaxf(fmaxf(mb, p1[r + 2]), p1[r + 3]); }
    const float mx = swapmax(fmaxf(ma, mb));
    bool resc = false;
    if (first) {
        mhat = mx;
#pragma unroll
        for (int r = 0; r < 16; ++r) { p0[r] -= mx; p1[r] -= mx; negm[r] = -mx; }
    } else if (__any(mx > THR)) {
        const float dl = fmaxf(mx, 0.f); mhat += dl;
#pragma unroll
        for (int r = 0; r < 16; ++r) { p0[r] -= dl; p1[r] -= dl; negm[r] = -mhat; }
        const float f = __builtin_amdgcn_exp2f(-dl); l *= f;
        if (hi == 0) wsf[r32] = f;
        resc = true;
    }
    return resc;
}
#define ATT_EL(e) ((e) < 16 ? p0[(e) & 15] : p1[(e) & 15])
template <int DVB, bool DO_PV>
__device__ __forceinline__ void step_pv_sm(const ALAS char* Vs, s16x4 (&vlo)[4], s16x4 (&vhi)[4], f32x16 (&o)[DVB], const u32x4 (&pwo)[4], f32x16& p0, f32x16& p1, u32x4 (&pwn)[4], float& l, int lane, int hi) {
    float s0 = 0.f, s1 = 0.f; unsigned pk[16];
    if (!DO_PV) {
#pragma unroll
        for (int r = 0; r < 16; ++r) { p0[r] = __builtin_amdgcn_exp2f(p0[r]); p1[r] = __builtin_amdgcn_exp2f(p1[r]); s0 += p0[r]; s1 += p1[r]; }
#pragma unroll
        for (int t = 0; t < 16; ++t) pk[t] = cvtpk(ATT_EL(2 * t), ATT_EL(2 * t + 1));
    } else {
        constexpr int NM = DVB * 4, EPG = 32 / NM;
        const ALAS char* vp = Vs + ((lane >> 4) & 1) * 32 + (lane & 3) * 8 + (4 * hi + ((lane & 15) >> 2)) * 64;
        constexpr int LA = 4;
        __builtin_amdgcn_sched_barrier(0);
#pragma unroll
        for (int j = 0; j < NM; ++j) {
            const bf16x8 vf = (bf16x8){vlo[j % LA][0], vlo[j % LA][1], vlo[j % LA][2], vlo[j % LA][3], vhi[j % LA][0], vhi[j % LA][1], vhi[j % LA][2], vhi[j % LA][3]};
            o[j >> 2] = __builtin_amdgcn_mfma_f32_32x32x16_bf16(__builtin_bit_cast(bf16x8, pwo[j & 3]), vf, o[j >> 2], 0, 0, 0);
#pragma unroll
            for (int u = 0; u < EPG; ++u) { const int e = j * EPG + u;
                if (e < 16) { p0[e & 15] = __builtin_amdgcn_exp2f(p0[e & 15]); } else { p1[e & 15] = __builtin_amdgcn_exp2f(p1[e & 15]); } }
            if (j * EPG < 16) asm volatile("" : "+v"(p0) :: "memory"); else asm volatile("" : "+v"(p1) :: "memory");
            if (j + LA < NM) { vlo[j % LA] = vtr(vp + ((j + LA) >> 2) * 4096 + ((j + LA) & 3) * 1024); vhi[j % LA] = vtr(vp + ((j + LA) >> 2) * 4096 + ((j + LA) & 3) * 1024 + 512); }
            asm volatile("" ::: "memory");
            if (j > 0) {
#pragma unroll
                for (int u = 0; u < EPG; u += 2) { const int e = (j - 1) * EPG + u; s0 += ATT_EL(e); s1 += ATT_EL(e + 1); pk[e >> 1] = cvtpk(ATT_EL(e), ATT_EL(e + 1)); asm volatile("" : "+v"(pk[e >> 1])); }
                asm volatile("" : "+v"(s0), "+v"(s1));
            }
            asm volatile("" : "+v"(o[j >> 2]));
            __builtin_amdgcn_sched_barrier(0);
        }
#pragma unroll
        for (int u = 0; u < EPG; u += 2) { const int e = (NM - 1) * EPG + u; s0 += ATT_EL(e); s1 += ATT_EL(e + 1); pk[e >> 1] = cvtpk(ATT_EL(e), ATT_EL(e + 1)); }
    }
#pragma unroll
    for (int k = 0; k < 4; ++k) pwn[k] = (u32x4){pk[4 * k], pk[4 * k + 1], pk[4 * k + 2], pk[4 * k + 3]};
    l += s0 + s1;
}
#undef ATT_EL
template <int DVB> __device__ __forceinline__ void rescale_o(f32x16 (&o)[DVB], ALAS float* wsf, int hi) {
    float fr_[16];
#pragma unroll
    for (int r = 0; r < 16; ++r) fr_[r] = wsf[crow(r, hi)];
#pragma unroll
    for (int db = 0; db < DVB; ++db)
#pragma unroll
        for (int r = 0; r < 16; ++r) o[db][r] *= fr_[r];
}
#define ATT_WAIT_BAR(N) asm volatile("s_waitcnt vmcnt(" #N ") lgkmcnt(0)\n\ts_barrier" ::: "memory")
#define ATT_BAR() asm volatile("s_waitcnt lgkmcnt(0)\n\ts_barrier" ::: "memory")

constexpr int WSF_OFF = 131072, OST_OFF = 65536;

struct ADesc { int NW, NT, nlo, wrow0, crow0, qrow0, kvh; };
__device__ __forceinline__ ADesc a_desc(int L) {
    int pair, qb; if (L < 2048) { pair = L >> 5; qb = L & 31; } else { pair = (L - 2048) >> 2; qb = 32 + ((L - 2048) & 3); }
    const int b = pair >> 2; ADesc d; d.kvh = pair & 3;
    const bool lat = qb < 32; const int p0 = lat ? qb * 64 : 0;
    d.nlo = lat ? (p0 == 0 ? 2 : (p0 == 64 ? 1 : 0)) : 0; const int nhi = lat ? (p0 == 1984 ? 2 : (p0 == 1920 ? 3 : 4)) : -1;
    d.NW = lat ? (nhi - d.nlo + 1) : 0; d.NT = d.NW + 4;
    d.wrow0 = b * 2048 + p0 - 128 + 64 * d.nlo; d.crow0 = LROWS + b * 256;
    d.qrow0 = lat ? b * 2048 + p0 : LROWS + b * 256 + (qb - 32) * 64;
    return d;
}
__device__ __forceinline__ void phase_A(ALAS char* shm, const bf16_t* Q, const bf16_t* K, const bf16_t* V, bf16_t* O, const float* sink, int first, int step, int U) {
    int tid_ = threadIdx.x; asm volatile("" : "+v"(tid_));
    const int tid = tid_, lane = tid & 63, r32 = lane & 31, hi = lane >> 5; const int wid = __builtin_amdgcn_readfirstlane(tid >> 6);
    constexpr int STG = 16384, KVP = 256;
    if (first >= U) return;
    const int g = wid & 3, half = wid >> 2;
    const bf16_t* klane = K + (size_t)(8 * wid + (lane >> 3)) * KVP + (((lane & 7) ^ ((wid & 1) * 4 + (lane >> 4))) << 3);
    const bf16_t* vlane = V + (size_t)(16 * (wid & 3) + (lane >> 2)) * KVP + (wid >> 2) * 32 + (lane & 3) * 8;
    const unsigned dst0 = (unsigned)(uintptr_t)shm + wid * 1024;
    ALAS float* wsf = (ALAS float*)(shm + WSF_OFF) + wid * 64;
#define A_ROWOF(d, n) ((n) < (d).NW ? (d).wrow0 + 64 * (n) : (d).crow0 + 64 * ((n) - (d).NW))
#define A_QLOAD(dst, d) do { const bf16_t* Qw_ = Q + (size_t)((d).qrow0 + 32 * half + r32) * 1024 + ((d).kvh * 4 + g) * 64 + hi * 8; \
        _Pragma("unroll") for (int d0 = 0; d0 < 4; ++d0) dst[d0] = *(const bf16x8*)(Qw_ + d0 * 16); } while (0)
    int L = first; ADesc cur = a_desc(L); int gb = 0;
    bf16x8 qr[4], qn[4];
    A_QLOAD(qr, cur);
    { const size_t r0_ = (size_t)A_ROWOF(cur, 0) * KVP + cur.kvh * 64, r1_ = (size_t)A_ROWOF(cur, 1) * KVP + cur.kvh * 64;
      glds16(klane + r0_, RFL(dst0)); glds16(vlane + r0_, RFL(dst0 + 8192)); glds16(klane + r1_, RFL(dst0 + STG)); glds16(vlane + r1_, RFL(dst0 + STG + 8192)); }
    ATT_WAIT_BAR(2);
    for (;;) {
        const int Ln = L + step; const bool has_next = Ln < U; const ADesc nxt = has_next ? a_desc(Ln) : cur;
        const int NT = cur.NT, NW = cur.NW, nlo = cur.nlo, head = cur.kvh * 4 + g;
        float mhat = sink[head] * 1.4426950408889634f, l = (hi == 0) ? 1.0f : 0.0f;
        f32x16 o[2], negm;
#pragma unroll
        for (int r = 0; r < 16; ++r) { o[0][r] = 0.f; o[1][r] = 0.f; negm[r] = -mhat; }
        u32x4 pw[4], pwn[4]; f32x16 sp0, sp1; s16x4 vlo[4], vhi[4];
#define A_MKDMA(n) const int t_ = (n) + 2; const bool own_ = t_ < NT; const bool on_ = own_ || has_next; \
        const size_t ro_ = own_ ? (size_t)A_ROWOF(cur, t_) * KVP + cur.kvh * 64 : (size_t)A_ROWOF(nxt, t_ - NT) * KVP + nxt.kvh * 64; \
        const DmaA dma_{klane + ro_, vlane + ro_, dst0 + ((gb + t_) & 3) * STG, on_}
#define A_ENDBAR(n) do { if ((n) + 2 < NT || has_next) ATT_WAIT_BAR(2); else ATT_WAIT_BAR(0); } while (0)
#define A_QKSTEP(n, D, RES, PV_) do { const ALAS char* sb_ = shm + ((gb + (n)) & 3) * STG; const ALAS char* vs_ = shm + ((gb + (n) - 1) & 3) * STG + 8192; const int np_ = nlo + (n); \
        if ((n) < NW && (np_ == 0 || np_ == 4)) RES = step_qk<true, PV_>(D, sb_, vs_, vlo, vhi, qr, sp0, sp1, negm, mhat, l, wsf, lane, r32, hi, false, 64 * np_ - 128 - 32 * half - r32); \
        else RES = step_qk<false, PV_>(D, sb_, vs_, vlo, vhi, qr, sp0, sp1, negm, mhat, l, wsf, lane, r32, hi, false, 0); } while (0)
        { bool rs_; { A_MKDMA(0); A_QKSTEP(0, dma_, rs_, false); } step_pv_sm<2, false>(shm, vlo, vhi, o, pw, sp0, sp1, pwn, l, lane, hi); if (rs_) rescale_o<2>(o, wsf, hi);
#pragma unroll
          for (int i = 0; i < 4; ++i) pw[i] = pwn[i];
          A_ENDBAR(0); }
        for (int n = 1; n < NT; ++n) { bool rs_; { A_MKDMA(n); A_QKSTEP(n, dma_, rs_, true); }
            step_pv_sm<2, true>(shm + ((gb + n - 1) & 3) * STG + 8192, vlo, vhi, o, pw, sp0, sp1, pwn, l, lane, hi); if (rs_) rescale_o<2>(o, wsf, hi);
#pragma unroll
            for (int i = 0; i < 4; ++i) pw[i] = pwn[i];
            A_ENDBAR(n); }
        { const DmaA nodma{klane, vlane, 0u, false}; step_y<2>(nodma, shm + ((gb + NT - 1) & 3) * STG + 8192, o, pw, lane, hi); }
#undef A_MKDMA
#undef A_ENDBAR
#undef A_QKSTEP
        if (has_next) A_QLOAD(qn, nxt);
        l = swapadd(l);
        if (hi == 0) wsf[32 + r32] = l;
        float rli[16];
#pragma unroll
        for (int r = 0; r < 16; ++r) rli[r] = __builtin_amdgcn_rcpf(wsf[32 + crow(r, hi)]);
        ALAS unsigned short* stg = (ALAS unsigned short*)(shm + OST_OFF) + wid * 2048;
#pragma unroll
        for (int r = 0; r < 16; ++r) { const int orow = crow(r, hi);
#pragma unroll
            for (int db = 0; db < 2; ++db) stg[orow * 64 + db * 32 + r32] = f2bf(o[db][r] * rli[r]); }
        bf16_t* Ow = O + (size_t)(cur.qrow0 + 32 * half) * 1024 + head * 64;
#pragma unroll
        for (int i = 0; i < 4; ++i) { const int row = i * 8 + (lane >> 3), ch = lane & 7; const u32x4 v = *(const ALAS u32x4*)(stg + row * 64 + ch * 8); *(u32x4*)(Ow + (size_t)row * 1024 + ch * 8) = v; }
        if (!has_next) break;
        gb = (gb + NT) & 3; cur = nxt; L = Ln;
#pragma unroll
        for (int d0 = 0; d0 < 4; ++d0) qr[d0] = qn[d0];
    }
#undef A_ROWOF
#undef A_QLOAD
}

__device__ __forceinline__ void unit_B(ALAS char* shm, int b, int h, int qb, const bf16_t* Q, const bf16_t* K, const bf16_t* V, bf16_t* O, float lam, float osc, const float* subg) {
    int tid_ = threadIdx.x; asm volatile("" : "+v"(tid_));
    const int tid = tid_, lane = tid & 63, r32 = lane & 31, hi = lane >> 5; const int wid = __builtin_amdgcn_readfirstlane(tid >> 6);
    constexpr int STG = 32768, KVP = 1024;
    const bool lat = qb < 16;
    const int NW = lat ? 32 : 0, NT = NW + 4;
    const int wrow0 = b * 2048, crow0 = LROWS + b * 256;
    const int m = wid & 1, sub = wid >> 1;
    const int qrow = (lat ? b * 2048 + qb * 128 : LROWS + b * 256 + (qb - 16) * 128) + 32 * sub;
    const bf16_t* Qw = Q + (size_t)qrow * 1024 + h * 128 + m * 64;
    bf16x8 qr[4];
#pragma unroll
    for (int d0 = 0; d0 < 4; ++d0) qr[d0] = *(const bf16x8*)(Qw + (size_t)r32 * 1024 + d0 * 16 + hi * 8);
    const bf16_t* ksrc = K + (size_t)(8 * wid + (lane >> 3)) * KVP + h * 128 + (((lane & 7) ^ ((wid & 1) * 4 + (lane >> 4))) << 3);
    const bf16_t* vsrc = V + (size_t)(16 * (wid & 3) + (lane >> 2)) * KVP + h * 128 + (wid >> 2) * 32 + (lane & 3) * 8;
    const unsigned dst0 = (unsigned)(uintptr_t)shm + wid * 1024;
    ALAS float* wsf = (ALAS float*)(shm + WSF_OFF) + wid * 64;
    float mhat = 0.f, l = 0.f;
    f32x16 o[4], negm;
#pragma unroll
    for (int r = 0; r < 16; ++r) negm[r] = 0.f;
#pragma unroll
    for (int db = 0; db < 4; ++db)
#pragma unroll
        for (int r = 0; r < 16; ++r) o[db][r] = 0.f;
#define ROWOF(n) ((n) < NW ? wrow0 + 64 * (n) : crow0 + 64 * ((n) - NW))
#define DMA_TILE(t) do { const size_t ro_ = (size_t)ROWOF(t) * KVP; const unsigned sb_ = dst0 + ((t) & 3) * STG; \
        glds16(ksrc + ro_, RFL(sb_)); glds16(ksrc + ro_ + 64, RFL(sb_ + 8192)); glds16(vsrc + ro_, RFL(sb_ + 16384)); glds16(vsrc + ro_ + 64, RFL(sb_ + 24576)); } while (0)
    DMA_TILE(0); DMA_TILE(1);
    ATT_WAIT_BAR(4);
    u32x4 pw[4];
#define MKDMA(t) const int t_ = (t); const size_t ro_ = (size_t)ROWOF(t_ < NT ? t_ : NT - 1) * KVP; const DmaB dma_{ksrc + ro_, vsrc + ro_, dst0 + (t_ & 3) * STG, true}
#define YSTEP(n, D) step_y<4>(D, shm + ((n) & 3) * STG + 16384, o, pw, lane, hi)
#define ENDBAR(n) do { if ((n) + 1 < NT) ATT_WAIT_BAR(4); else ATT_WAIT_BAR(0); } while (0)
    const DmaB nodma{ksrc, vsrc, 0u, false};
    f32x16 sp0, sp1; u32x4 pwn[4]; s16x4 vlo[4], vhi[4];
    { bool rs_; { MKDMA(2); rs_ = step_qk<false, false>(dma_, shm + m * 8192, shm, vlo, vhi, qr, sp0, sp1, negm, mhat, l, wsf, lane, r32, hi, true, 0); } step_pv_sm<4, false>(shm, vlo, vhi, o, pw, sp0, sp1, pwn, l, lane, hi); (void)rs_;
#pragma unroll
      for (int i = 0; i < 4; ++i) pw[i] = pwn[i];
      ENDBAR(0); }
#define BSTEP(n, PWO, PWN, CHK) do { bool rs_; { MKDMA((n) + 2); rs_ = step_qk<false, true, DmaB, CHK>(dma_, shm + ((n) & 3) * STG + m * 8192, shm + (((n) - 1) & 3) * STG + 16384, vlo, vhi, qr, sp0, sp1, negm, mhat, l, wsf, lane, r32, hi, false, 0); } \
        step_pv_sm<4, true>(shm + (((n) - 1) & 3) * STG + 16384, vlo, vhi, o, PWO, sp0, sp1, PWN, l, lane, hi); if (rs_) rescale_o<4>(o, wsf, hi); \
        ENDBAR(n); } while (0)
    for (int n = 1; n + 1 < NT; n += 2) { BSTEP(n, pw, pwn, true); BSTEP(n + 1, pwn, pw, false); }
    BSTEP(NT - 1, pw, pwn, true);
#pragma unroll
    for (int i = 0; i < 4; ++i) pw[i] = pwn[i];
#undef BSTEP
    YSTEP(NT - 1, nodma);
#undef MKDMA
#undef YSTEP
#undef ENDBAR
#undef ROWOF
#undef DMA_TILE
    l = swapadd(l);
    if (hi == 0) wsf[32 + r32] = l;
    float rli[16];
#pragma unroll
    for (int r = 0; r < 16; ++r) rli[r] = __builtin_amdgcn_rcpf(wsf[32 + crow(r, hi)]);
    ALAS float* cb = (ALAS float*)(shm + sub * 16384);
    if (m == 1) {
#pragma unroll
        for (int r = 0; r < 16; ++r) { const int orow = crow(r, hi); const float sc = rli[r] * lam;
#pragma unroll
            for (int db = 0; db < 4; ++db) cb[orow * 128 + db * 32 + r32] = o[db][r] * sc; }
    }
    __syncthreads();
    if (m == 0) {
        float ss[16];
#pragma unroll
        for (int r = 0; r < 16; ++r) { const int orow = crow(r, hi); float q = 0.f;
#pragma unroll
            for (int db = 0; db < 4; ++db) { const float x = o[db][r] * rli[r] - cb[orow * 128 + db * 32 + r32]; o[db][r] = x; q += x * x; }
            ss[r] = q; }
#pragma unroll
        for (int r = 0; r < 16; ++r) { const float q = half_sum32(ss[r]);
            ss[r] = osc * __builtin_amdgcn_rsqf(q * (1.0f / 128.0f) + 1e-5f); }
        float gsub[4];
#pragma unroll
        for (int db = 0; db < 4; ++db) gsub[db] = subg[db * 32 + r32];
        ALAS unsigned short* stg = (ALAS unsigned short*)(shm + OST_OFF) + sub * 4096;
#pragma unroll
        for (int r = 0; r < 16; ++r) { const int orow = crow(r, hi);
#pragma unroll
            for (int db = 0; db < 4; ++db) stg[orow * 128 + db * 32 + r32] = f2bf(o[db][r] * ss[r] * gsub[db]); }
        bf16_t* Ow = O + (size_t)qrow * 1024 + h * 128;
#pragma unroll
        for (int i = 0; i < 8; ++i) { const int row = i * 4 + (lane >> 4), ch = lane & 15; const u32x4 v = *(const ALAS u32x4*)(stg + row * 128 + ch * 8); *(u32x4*)(Ow + (size_t)row * 1024 + ch * 8) = v; }
    }
    __syncthreads();
}
#undef RFL
#undef ATT_WAIT_BAR
#undef ATT_BAR
#undef ALAS
}

#ifndef MK_PER_PHASE
#define MK_PER_PHASE 0
#endif
constexpr int NWAVES = 8;
constexpr int DM = 1024, NBATCH = 16, SEQ = 2048, CTXL = 256, LROWS = NBATCH * SEQ, CROWS = NBATCH * CTXL, MROWS = LROWS + CROWS, NEXP = 16, DEPTH = 4;
constexpr float DN_ALPHA = 1.6817928305074292f;
constexpr float LN_EPS = 1e-6f;
constexpr float QSCALE = 0.125f * 1.4426950408889634f;
constexpr int NPHASE = 2 + 8 * DEPTH;

constexpr size_t MiB = 1u << 20;
constexpr size_t WS_CTL = 0, CTL_ZERO_BYTES = 1 * MiB;
constexpr size_t WS_MOD = 1 * MiB;
constexpr size_t WS_ROPE = 3 * MiB;
constexpr size_t WS_TOKE = 4 * MiB;
constexpr size_t WS_TOKW = 4 * MiB + 512 * 1024;
constexpr size_t WS_TOKP = 5 * MiB;
constexpr size_t WS_BCNT = 5 * MiB + 512 * 1024;
constexpr size_t WS_META = 5 * MiB + 768 * 1024;
constexpr size_t WS_ROWL = 6 * MiB;
constexpr size_t WS_XC = 662 * MiB;
constexpr size_t WS_WQKVA = 16 * MiB, WS_WOA = 22 * MiB, WS_WQKVB = 26 * MiB, WS_WOB = 38 * MiB;
constexpr size_t WS_WGU = 42 * MiB;
constexpr size_t WS_WDN = 170 * MiB;
constexpr size_t WS_HL = 234 * MiB;
constexpr size_t WS_Q = 306 * MiB, WS_K = 378 * MiB, WS_V = 450 * MiB;
constexpr size_t WS_XG = 306 * MiB;
constexpr size_t WS_AL = 522 * MiB;
constexpr size_t WS_XB = 598 * MiB;
constexpr size_t WS_END = 670 * MiB;
constexpr int CW_BAR = 4096;

constexpr int RING_BYTES = 135168, MISC_OFF = RING_BYTES, ROWTAB_OFF = 137216  , LDS_BYTES = 147456;

#define GAS __attribute__((address_space(1)))
#define LAS __attribute__((address_space(3)))
typedef unsigned short bf16;
typedef float f32x4 __attribute__((ext_vector_type(4)));
typedef unsigned u32x4 __attribute__((ext_vector_type(4)));
typedef unsigned u32x2 __attribute__((ext_vector_type(2)));
typedef GAS unsigned gu32;
#define RLX_AGENT __ATOMIC_RELAXED, __HIP_MEMORY_SCOPE_AGENT
#define LDS_WAIT() asm volatile("s_waitcnt lgkmcnt(0)" ::: "memory")
__device__ __forceinline__ unsigned f2bf(float f) { unsigned u = __builtin_bit_cast(unsigned, f); return (u + 0x7fffu + ((u >> 16) & 1u)) >> 16; }
typedef float pk_f32x2 __attribute__((ext_vector_type(2))); typedef __bf16 pk_bf16x2 __attribute__((ext_vector_type(2)));
__device__ __forceinline__ unsigned pk2(float lo, float hi) { pk_f32x2 v = {lo, hi}; pk_bf16x2 b = __builtin_convertvector(v, pk_bf16x2); return __builtin_bit_cast(unsigned, b); }
__device__ __forceinline__ float bflo(unsigned w) { return __uint_as_float(w << 16); }
__device__ __forceinline__ float bfhi(unsigned w) { return __uint_as_float(w & 0xffff0000u); }

#define XB_TMO      128
#define XB_XCNT(j)  (256  + 64 * (j))
#define XB_XSUB(j)  (1280 + 64 * (j))
#define XB_XGEN(j)  (2304 + 64 * (j))
#define XB_TOP      3328
#define XB_TOPGEN   3392
#define XCD_BAR_WORDS 3456
#define XB_SPIN_CAP (1u << 18)
__device__ __forceinline__ unsigned xb_ld(unsigned* p)              { return __hip_atomic_load(p, __ATOMIC_RELAXED, __HIP_MEMORY_SCOPE_AGENT); }
__device__ __forceinline__ unsigned xb_add(unsigned* p, unsigned v) { return __hip_atomic_fetch_add(p, v, __ATOMIC_RELAXED, __HIP_MEMORY_SCOPE_AGENT); }
__device__ __forceinline__ unsigned xb_xcc_id() { return (unsigned)__builtin_amdgcn_s_getreg((3 << 11) | 20) & 0xFu; }
#define XB_SPIN(cond, bar) do { unsigned _sp = 0; while (cond) { __builtin_amdgcn_s_sleep(1); \
    if ((++_sp & 255u) == 0u) { if (xb_ld(&(bar)[XB_TMO])) break; if (_sp > XB_SPIN_CAP) { atomicAdd(&(bar)[XB_TMO], 1u); break; } } } } while (0)
struct XcdBarrier { unsigned* bar; unsigned x; volatile LAS unsigned* st; };
__device__ __forceinline__ XcdBarrier xcd_barrier_post(unsigned* bar, volatile LAS unsigned* st) {
    XcdBarrier b; b.bar = bar; b.x = xb_xcc_id(); b.st = st;
    if (threadIdx.x == 0) (void)xb_add(&bar[XB_XCNT(b.x)], 1u);
    return b;
}
__device__ __forceinline__ void xcd_barrier_complete(unsigned* bar, unsigned x, unsigned& nloc, unsigned& nx) {
    const unsigned G = gridDim.x * gridDim.y * gridDim.z;
    unsigned sum, cnt, mine, sp = 0u;
    for (;;) {
        sum = 0u; cnt = 0u; mine = 0u;
#pragma unroll
        for (unsigned j = 0; j < 16; ++j) { const unsigned c = xb_ld(&bar[XB_XCNT(j)]); sum += c; cnt += (c > 0u) ? 1u : 0u; mine = (j == x) ? c : mine; }
        if (sum == G) break;
        __builtin_amdgcn_s_sleep(1);
        if ((++sp & 255u) == 0u) { if (xb_ld(&bar[XB_TMO])) break; if (sp > XB_SPIN_CAP) { atomicAdd(&bar[XB_TMO], 1u); break; } }
    }
    nloc = mine > 0u ? mine : 1u; nx = cnt > 0u ? cnt : 1u;
}
__device__ __forceinline__ void xcd_barrier(const XcdBarrier& b) {
    asm volatile("s_waitcnt vmcnt(0)" ::: "memory");
    __syncthreads();
    if (threadIdx.x == 0) {
        unsigned* bar = b.bar;
        __builtin_amdgcn_s_waitcnt(0);
        unsigned nloc = b.st[0], nx = b.st[1];
        if (nloc == 0u) { xcd_barrier_complete(bar, b.x, nloc, nx); b.st[0] = nloc; b.st[1] = nx; }
        const unsigned old = xb_add(&bar[XB_XSUB(b.x)], 1u);
        const unsigned gen = old / nloc;
        if (old + 1u == (gen + 1u) * nloc) {
            __builtin_amdgcn_fence(__ATOMIC_RELEASE, "agent");
            asm volatile("s_waitcnt vmcnt(0)" ::: "memory");
            const unsigned og = xb_add(&bar[XB_TOP], 1u);
            const unsigned tg = og / nx;
            if (og + 1u == (tg + 1u) * nx) xb_add(&bar[XB_TOPGEN], 1u);
            else XB_SPIN(xb_ld(&bar[XB_TOPGEN]) == tg, bar);
            __builtin_amdgcn_fence(__ATOMIC_ACQUIRE, "agent");
            xb_add(&bar[XB_XGEN(b.x)], 1u);
            asm volatile("s_waitcnt vmcnt(0)" ::: "memory");
        } else {
            XB_SPIN(xb_ld(&bar[XB_XGEN(b.x)]) == gen, bar);
            __builtin_amdgcn_fence(__ATOMIC_ACQUIRE, "agent");
            asm volatile("s_waitcnt vmcnt(0)" ::: "memory");
        }
    }
    __syncthreads();
}

struct Args { const float* in[22]; float* out; unsigned char* ws; int ph_lo, ph_hi; };

typedef const float* CFP_; typedef __attribute__((address_space(4))) const CFP_* KIn;
struct Frame {
    LAS unsigned char* lds; volatile LAS unsigned* MISC;
    int tid, lane, wave, vcu, G, gw, NGW, rpw;
    KIn in; float* out; unsigned char* ws;
};
__device__ __forceinline__ void fresh_in(Frame& F) { KIn p = (KIn)__builtin_amdgcn_kernarg_segment_ptr(); asm volatile("" : "+s"(p)); F.in = p; }

template <int X> __device__ __forceinline__ float lane_xor(float v) {
    if (X == 1) return __builtin_bit_cast(float, __builtin_amdgcn_update_dpp(0, __builtin_bit_cast(int, v), 0xB1, 0xF, 0xF, true));
    if (X == 2) return __builtin_bit_cast(float, __builtin_amdgcn_update_dpp(0, __builtin_bit_cast(int, v), 0x4E, 0xF, 0xF, true));
    return __builtin_bit_cast(float, __builtin_amdgcn_ds_swizzle(__builtin_bit_cast(int, v), (X << 10) | 0x1F));
}
template <int N> __device__ __forceinline__ float dpp_ror(float v) { return __builtin_bit_cast(float, __builtin_amdgcn_update_dpp(0, __builtin_bit_cast(int, v), 0x120 | N, 0xF, 0xF, true)); }
__device__ __forceinline__ float row_sum16(float v) { v += dpp_ror<8>(v); v += dpp_ror<4>(v); v += dpp_ror<2>(v); v += dpp_ror<1>(v); return v; }
__device__ __forceinline__ float half_sum(float v) { v = row_sum16(v);
    auto rr = __builtin_amdgcn_permlane16_swap(__float_as_uint(v), __float_as_uint(v), false, false); return __uint_as_float(rr[0]) + __uint_as_float(rr[1]); }
__device__ __forceinline__ float wave_sum(float v) {
    v = half_sum(v);
    auto rr = __builtin_amdgcn_permlane32_swap(__float_as_uint(v), __float_as_uint(v), false, false);
    return __uint_as_float(rr[0]) + __uint_as_float(rr[1]);
}
template <int MAP> __device__ __forceinline__ int map_row(int n) {
    if (MAP == 1) return (n & ~31) + 2 * (n & 15) + ((n >> 4) & 1);
    if (MAP == 2) return 8 * (n >> 2) + (n & 3);
    if (MAP == 3) return 8 * (n >> 2) + 4 + (n & 3);
    return n;
}
template <int MAP> __device__ __forceinline__ void transpose_item(const float* W, int K, int N, bf16* WT, LAS unsigned* scr, int item, int lane) {
    const int nblk = N / 64, kb = item / nblk, nb = item % nblk, k0 = 64 * kb, n0 = 64 * nb;
    const GAS float* src = (const GAS float*)W + (size_t)k0 * N + n0 + lane;
    float v[64];
#pragma unroll
    for (int t = 0; t < 64; ++t) v[t] = src[(size_t)t * N];
#pragma unroll
    for (int t = 0; t < 32; ++t) scr[lane * 33 + t] = pk2(v[2 * t], v[2 * t + 1]);
    LDS_WAIT(); asm volatile("" ::: "memory");
#pragma unroll
    for (int j = 0; j < 8; ++j) { const int row = j * 8 + (lane >> 3), ch = lane & 7; const LAS unsigned* sp = scr + row * 33 + ch * 4;
        u32x4 o; o.x = sp[0]; o.y = sp[1]; o.z = sp[2]; o.w = sp[3];
        *(GAS u32x4*)(WT + (size_t)map_row<MAP>(n0 + row) * K + k0 + ch * 8) = o; }
    LDS_WAIT(); asm volatile("" ::: "memory");
}
__device__ __forceinline__ void sincos_small(float x, float& s, float& c) {
    const float kf = rintf(x * 0.636619772367581f); const int k = (int)kf;
    float r = fmaf(-kf, 1.5703125f, x); r = fmaf(-kf, 4.837512969970703125e-4f, r); r = fmaf(-kf, 7.54978995489188216e-8f, r);
    const float r2 = r * r;
    const float sp = r + r * r2 * (-1.6666654611e-1f + r2 * (8.3321608736e-3f + r2 * (-1.9515295891e-4f)));
    const float cp = 1.0f - 0.5f * r2 + r2 * r2 * (4.166664568298827e-2f + r2 * (-1.388731625493765e-3f + r2 * 2.443315711809948e-5f));
    const int q = k & 3;
    s = (q == 0) ? sp : (q == 1) ? cp : (q == 2) ? -sp : -cp;
    c = (q == 0) ? cp : (q == 1) ? -sp : (q == 2) ? -cp : sp;
}

__device__ __forceinline__ void convert_experts(Frame& F, int layer, int w, int nw) {
    fresh_in(F);
    int t_ = threadIdx.x; asm volatile("" : "+v"(t_)); const int lane = t_ & 63;
    LAS unsigned* scr = (LAS unsigned*)(F.lds + F.wave * 16384);
    bf16* wgu = (bf16*)(F.ws + WS_WGU); bf16* wdn = (bf16*)(F.ws + WS_WDN);
    constexpr int I_G = 16 * 8, I_D = 8 * 16, N_G = 16 * I_G, N_D = 16 * I_D;
    for (int it = w; it < 2 * N_G + N_D; it += nw) {
        int r = it;
        if (r < N_G) { const int mi = layer * 16 + r / I_G, ii = r % I_G; transpose_item<2>(F.in[19] + (size_t)mi * 1024 * 512, 1024, 512, wgu + (size_t)mi * 1024 * 1024, scr, ii, lane); continue; } r -= N_G;
        if (r < N_G) { const int mi = layer * 16 + r / I_G, ii = r % I_G; transpose_item<3>(F.in[20] + (size_t)mi * 1024 * 512, 1024, 512, wgu + (size_t)mi * 1024 * 1024, scr, ii, lane); continue; } r -= N_G;
        { const int mi = layer * 16 + r / I_D, ii = r % I_D; transpose_item<0>(F.in[21] + (size_t)mi * 512 * 1024, 512, 1024, wdn + (size_t)mi * 1024 * 512, scr, ii, lane); }
    }
}
__device__ __forceinline__ void ph_prologue(Frame F) {
    { int t_ = threadIdx.x; asm volatile("" : "+v"(t_)); F.tid = t_; F.lane = t_ & 63; fresh_in(F); }
    const float* c = F.in[1]; const float* cctx = F.in[3]; const float* w_ada = F.in[4]; const float* b_ada = F.in[5];
    float* mod = (float*)(F.ws + WS_MOD);
    for (int task = F.vcu; task < 192; task += F.G) {
        const int li = task / 48, jc = task % 48;
        LAS float* s = (LAS float*)F.lds;
        LAS float* part = (LAS float*)(F.lds + 17 * 1024 * 4);
        for (int idx = F.tid; idx < 17 * 1024; idx += NWAVES * 64) { const int r = idx >> 10, k = idx & 1023; const float v = r < 16 ? c[r * 1024 + k] : cctx[k]; s[idx] = v / (1.0f + expf(-v)); }
        __syncthreads();
        const int ch = F.wave & 1, kq = F.wave >> 1, j = jc * 128 + ch * 64 + F.lane;
        const float* wu = w_ada + ((size_t)li * 1024 + kq * 256) * 6144 + jc * 128 + ch * 64;
        float acc[17];
#pragma unroll
        for (int r = 0; r < 17; ++r) acc[r] = 0.f;
        for (int kb = 0; kb < 8; ++kb) {
            float wv[32];
#pragma unroll
            for (int t = 0; t < 32; ++t) wv[t] = wu[(size_t)(32 * kb + t) * 6144 + F.lane];
            __builtin_amdgcn_sched_barrier(0);
#pragma unroll
            for (int k4 = 0; k4 < 8; ++k4)
#pragma unroll
                for (int r = 0; r < 17; ++r) { const f32x4 sv = *(const LAS f32x4*)(s + r * 1024 + kq * 256 + 32 * kb + 4 * k4);
                    acc[r] = fmaf(sv[0], wv[4 * k4], acc[r]); acc[r] = fmaf(sv[1], wv[4 * k4 + 1], acc[r]); acc[r] = fmaf(sv[2], wv[4 * k4 + 2], acc[r]); acc[r] = fmaf(sv[3], wv[4 * k4 + 3], acc[r]); }
            __builtin_amdgcn_sched_barrier(0);
        }
#pragma unroll
        for (int r = 0; r < 17; ++r) part[(kq * 17 + r) * 128 + ch * 64 + F.lane] = acc[r];
        __syncthreads();
        for (int idx = F.tid; idx < 17 * 128; idx += NWAVES * 64) { const int r = idx >> 7, jj = idx & 127;
            const float v = (part[(0 * 17 + r) * 128 + jj] + part[(1 * 17 + r) * 128 + jj]) + (part[(2 * 17 + r) * 128 + jj] + part[(3 * 17 + r) * 128 + jj]);
            mod[((size_t)li * 17 + r) * 6144 + jc * 128 + jj] = v + b_ada[li * 6144 + jc * 128 + jj]; }
        __syncthreads();
    }
    {
        float* rope = (float*)(F.ws + WS_ROPE);
        for (int idx = F.gw * 64 + F.lane; idx < 2048 * 32; idx += F.NGW * 64) { const int pos = idx >> 5, pi = idx & 31, j = pi & 15;
            const float ax = (float)(pi < 16 ? (pos >> 6) : (pos & 63)); const float inv = exp2f(-(float)j * (13.287712379549449f / 16.0f));
            float sn, cs; sincos_small(ax * inv, sn, cs); rope[idx * 2] = cs; rope[idx * 2 + 1] = sn; }
    }
    LAS unsigned* scr = (LAS unsigned*)(F.lds + F.wave * 16384);
    bf16* wqa = (bf16*)(F.ws + WS_WQKVA); bf16* woa = (bf16*)(F.ws + WS_WOA); bf16* wqb = (bf16*)(F.ws + WS_WQKVB); bf16* wob = (bf16*)(F.ws + WS_WOB);
    constexpr int I_QA = 16 * 24, I_O = 16 * 16, I_QB = 16 * 48;
    constexpr int N_QA = 2 * I_QA, N_OA = 2 * I_O, N_QB = 2 * I_QB, N_OB = 2 * I_O;
    constexpr int NITEMS = N_QA + N_OA + N_QB + N_OB;
    for (int it = F.gw; it < NITEMS; it += F.NGW) {
        int r = it;
        if (r < N_QA) { const int mi = r / I_QA, ii = r % I_QA; const int nb = ii % 24;
            if (nb < 20) transpose_item<1>(F.in[6] + (size_t)mi * 1024 * 1536, 1024, 1536, wqa + (size_t)mi * 1536 * 1024, scr, ii, F.lane);
            else transpose_item<0>(F.in[6] + (size_t)mi * 1024 * 1536, 1024, 1536, wqa + (size_t)mi * 1536 * 1024, scr, ii, F.lane);
            continue; } r -= N_QA;
        if (r < N_OA) { const int mi = r / I_O, ii = r % I_O; transpose_item<0>(F.in[7] + (size_t)mi * 1024 * 1024, 1024, 1024, woa + (size_t)mi * 1024 * 1024, scr, ii, F.lane); continue; } r -= N_OA;
        if (r < N_QB) { const int mi = r / I_QB, ii = r % I_QB; const int nb = ii % 48;
            if (nb < 32) transpose_item<1>(F.in[9] + (size_t)mi * 1024 * 3072, 1024, 3072, wqb + (size_t)mi * 3072 * 1024, scr, ii, F.lane);
            else transpose_item<0>(F.in[9] + (size_t)mi * 1024 * 3072, 1024, 3072, wqb + (size_t)mi * 3072 * 1024, scr, ii, F.lane);
            continue; } r -= N_QB;
        { const int mi = r / I_O, ii = r % I_O; transpose_item<0>(F.in[10] + (size_t)mi * 1024 * 1024, 1024, 1024, wob + (size_t)mi * 1024 * 1024, scr, ii, F.lane); }
    }
}

__device__ __forceinline__ void ld_f32(const float* p, int lane, f32x4 (&v)[4]) {
#pragma unroll
    for (int j = 0; j < 4; ++j) v[j] = ((const GAS f32x4*)p)[64 * j + lane];
}
__device__ __forceinline__ void ld_bf16(const bf16* p, int lane, f32x4 (&v)[4]) {
#pragma unroll
    for (int j = 0; j < 4; ++j) { const u32x2 w = ((const GAS u32x2*)p)[64 * j + lane]; v[j] = (f32x4){bflo(w.x), bfhi(w.x), bflo(w.y), bfhi(w.y)}; }
}
__device__ __forceinline__ void st_f32(float* p, int lane, const f32x4 (&v)[4]) {
#pragma unroll
    for (int j = 0; j < 4; ++j) ((GAS f32x4*)p)[64 * j + lane] = v[j];
}
__device__ __forceinline__ void st_bf16(bf16* p, int lane, const f32x4 (&v)[4]) {
#pragma unroll
    for (int j = 0; j < 4; ++j) { u32x2 w; w.x = pk2(v[j][0], v[j][1]); w.y = pk2(v[j][2], v[j][3]); ((GAS u32x2*)p)[64 * j + lane] = w; }
}
__device__ __forceinline__ void ln_core(f32x4 (&v)[4]) {
    float s = 0.f;
#pragma unroll
    for (int j = 0; j < 4; ++j) s += (v[j][0] + v[j][1]) + (v[j][2] + v[j][3]);
    const float mean = wave_sum(s) * (1.0f / DM); float q = 0.f;
#pragma unroll
    for (int j = 0; j < 4; ++j) { v[j] = v[j] - mean; q += (v[j][0] * v[j][0] + v[j][1] * v[j][1]) + (v[j][2] * v[j][2] + v[j][3] * v[j][3]); }
    const float rstd = __builtin_amdgcn_rsqf(wave_sum(q) * (1.0f / DM) + LN_EPS);
#pragma unroll
    for (int j = 0; j < 4; ++j) v[j] = v[j] * rstd;
}

__device__ __forceinline__ void ph_hl0(Frame F) {
    { int t_ = threadIdx.x; asm volatile("" : "+v"(t_)); F.tid = t_; F.lane = t_ & 63; fresh_in(F); }
    const float* mod = (const float*)(F.ws + WS_MOD); bf16* HL = (bf16*)(F.ws + WS_HL);
    const int r0 = F.gw * F.rpw, r1 = min(r0 + F.rpw, MROWS);
    int bcur = -1; f32x4 sc[4], sh[4], v[4], nx[4];
    if (r0 < r1) ld_f32(r0 < LROWS ? F.in[0] + (size_t)r0 * DM : F.in[2] + (size_t)(r0 - LROWS) * DM, F.lane, v);
    for (int row = r0; row < r1; ++row) {
        const int b = row < LROWS ? row >> 11 : 16;
        if (b != bcur) { bcur = b; const float* mb = mod + ((size_t)0 * 17 + b) * 6144; ld_f32(mb, F.lane, sh); ld_f32(mb + 1024, F.lane, sc); }
        if (row + 1 < r1) { const int rn = row + 1; ld_f32(rn < LROWS ? F.in[0] + (size_t)rn * DM : F.in[2] + (size_t)(rn - LROWS) * DM, F.lane, nx); }
        st_bf16((bf16*)(F.ws + WS_XB) + (size_t)row * DM, F.lane, v);
#pragma unroll
        for (int j = 0; j < 4; ++j) v[j] = v[j] * (sc[j] + 1.0f) + sh[j];
        st_bf16(HL + (size_t)row * DM, F.lane, v);
#pragma unroll
        for (int j = 0; j < 4; ++j) v[j] = nx[j];
    }
}

__device__ __forceinline__ void ph_ln1(Frame F, int li, int Mr) {
    { int t_ = threadIdx.x; asm volatile("" : "+v"(t_)); F.tid = t_; F.lane = t_ & 63; fresh_in(F); }
    const float* mod = (const float*)(F.ws + WS_MOD);
    const bf16* AL = (const bf16*)(F.ws + WS_AL); bf16* H2 = (bf16*)(F.ws + WS_HL);
    int* toke = (int*)(F.ws + WS_TOKE); float* tokw = (float*)(F.ws + WS_TOKW); int* bcnt = (int*)(F.ws + WS_BCNT);
    bf16* xb = (bf16*)(F.ws + WS_XB); static_assert(WS_XC == WS_XB + (size_t)LROWS * DM * 2, "context rows follow the latent rows");
    LAS float* wr = (LAS float*)F.lds;
    { const float* wrg = F.in[17];
      for (int idx = F.tid; idx < 1024 * 16; idx += NWAVES * 64) { const int k = idx >> 4, e = idx & 15; const int j = k >> 8, ln = (k & 255) >> 2, cc = k & 3, q = e >> 2, t = e & 3;
          wr[((((j * 4 + cc) * 4 + q) * 64 + ln) << 2) + t] = wrg[idx]; } }
    if (F.tid < 16) F.MISC[16 + F.tid] = 0u;
    __syncthreads();
    const int qg = F.lane >> 4;
    float rb4[4];
#pragma unroll
    for (int i = 0; i < 4; ++i) rb4[i] = F.in[18][4 * qg + i];
    f32x4 lg[4], lb[4]; ld_f32(F.in[13] + li * DM, F.lane, lg); ld_f32(F.in[14] + li * DM, F.lane, lb);
    const int wb = F.vcu * NWAVES * F.rpw, we = min(wb + NWAVES * F.rpw, Mr), ppw = (((we - wb) >> 1) + NWAVES - 1) / NWAVES;
    const int r0 = wb + 2 * F.wave * ppw, r1 = min(r0 + 2 * ppw, we);
    int bcur = -1; f32x4 g1[4], sc2[4], sh2[4]; u32x2 nv[4], na[4];
#define LN1_LDX(R) do { const int rn_ = (R); const bf16* xs_ = xb + (size_t)rn_ * DM; \
        _Pragma("unroll") for (int j = 0; j < 4; ++j) { nv[j] = ((const GAS u32x2*)xs_)[64 * j + F.lane]; na[j] = ((const GAS u32x2*)(AL + (size_t)rn_ * DM))[64 * j + F.lane]; } } while (0)
    if (r0 < r1) LN1_LDX(r0);
    typedef float f32x2p __attribute__((ext_vector_type(2)));
    for (int row0 = r0; row0 < r1; row0 += 2) {
        f32x4 h[2][4];
        { const int b = row0 < LROWS ? row0 >> 11 : 16;
            if (b != bcur) { bcur = b; const float* mb = mod + ((size_t)li * 17 + b) * 6144; ld_f32(mb + 2048, F.lane, g1); ld_f32(mb + 3072, F.lane, sh2); ld_f32(mb + 4096, F.lane, sc2);
#pragma unroll
                for (int j = 0; j < 4; ++j) sc2[j] = sc2[j] + 1.0f; } }
#pragma unroll
        for (int s = 0; s < 2; ++s) {
            const int row = row0 + s;
            bf16* xo = xb + (size_t)row * DM;
            f32x4 v[4];
#pragma unroll
            for (int j = 0; j < 4; ++j) v[j] = (f32x4){bflo(nv[j].x), bfhi(nv[j].x), bflo(nv[j].y), bfhi(nv[j].y)} * DN_ALPHA + g1[j] * (f32x4){bflo(na[j].x), bfhi(na[j].x), bflo(na[j].y), bfhi(na[j].y)};
            if (row0 + s + 1 < r1) LN1_LDX(row0 + s + 1);
            ln_core(v);
#pragma unroll
            for (int j = 0; j < 4; ++j) v[j] = v[j] * lg[j] + lb[j];
            st_bf16(xo, F.lane, v);
#pragma unroll
            for (int j = 0; j < 4; ++j) v[j] = v[j] * sc2[j] + sh2[j];
            st_bf16(H2 + (size_t)row * DM, F.lane, v);
#pragma unroll
            for (int j = 0; j < 4; ++j) h[s][j] = v[j];
        }
        f32x2p lgA[8], lgB[8];
#pragma unroll
        for (int e = 0; e < 8; ++e) { lgA[e] = (f32x2p){0.f, 0.f}; lgB[e] = (f32x2p){0.f, 0.f}; }
#pragma unroll
        for (int j = 0; j < 4; ++j) {
#pragma unroll
            for (int hf = 0; hf < 2; ++hf) {
                f32x4 w4[8];
#pragma unroll
                for (int i = 0; i < 8; ++i) w4[i] = *(const LAS f32x4*)(wr + (((j * 16 + hf * 8 + i) * 64 + F.lane) << 2));
                __builtin_amdgcn_sched_barrier(0);
#pragma unroll
                for (int c2 = 0; c2 < 2; ++c2) { const int cc = hf * 2 + c2; const f32x2p ha = (f32x2p){h[0][j][cc], h[0][j][cc]}, hb = (f32x2p){h[1][j][cc], h[1][j][cc]};
#pragma unroll
                    for (int q = 0; q < 4; ++q) { const f32x4 w = w4[c2 * 4 + q]; const f32x2p wl = (f32x2p){w[0], w[1]}, wh = (f32x2p){w[2], w[3]};
                        lgA[2 * q] = __builtin_elementwise_fma(ha, wl, lgA[2 * q]); lgA[2 * q + 1] = __builtin_elementwise_fma(ha, wh, lgA[2 * q + 1]);
                        lgB[2 * q] = __builtin_elementwise_fma(hb, wl, lgB[2 * q]); lgB[2 * q + 1] = __builtin_elementwise_fma(hb, wh, lgB[2 * q + 1]); } }
#pragma unroll
                for (int e = 0; e < 8; ++e) asm volatile("" : "+v"(lgA[e]), "+v"(lgB[e]));
                __builtin_amdgcn_sched_barrier(0);
            }
        }
#pragma unroll
        for (int s = 0; s < 2; ++s) {
            const int row = row0 + s;
            float lgt[16];
#pragma unroll
            for (int e = 0; e < 8; ++e) { lgt[2 * e] = s ? lgB[e][0] : lgA[e][0]; lgt[2 * e + 1] = s ? lgB[e][1] : lgA[e][1]; }
            float y8[8];
#pragma unroll
            for (int e = 0; e < 8; ++e) { auto rr = __builtin_amdgcn_permlane32_swap(__float_as_uint(lgt[e]), __float_as_uint(lgt[e + 8]), false, false); y8[e] = __uint_as_float(rr[0]) + __uint_as_float(rr[1]); }
            float z[4];
#pragma unroll
            for (int i = 0; i < 4; ++i) { auto rr = __builtin_amdgcn_permlane16_swap(__float_as_uint(y8[i]), __float_as_uint(y8[i + 4]), false, false); z[i] = __uint_as_float(rr[0]) + __uint_as_float(rr[1]); }
#pragma unroll
            for (int i = 0; i < 4; ++i) z[i] = row_sum16(z[i]);
            float sg[4], bs[4];
#pragma unroll
            for (int i = 0; i < 4; ++i) { sg[i] = __builtin_amdgcn_rcpf(1.0f + __builtin_amdgcn_exp2f(-1.4426950408889634f * z[i])); bs[i] = sg[i] + rb4[i]; }
            float m0 = bs[0], v0 = sg[0]; int i0 = 0;
#pragma unroll
            for (int t = 1; t < 4; ++t) if (bs[t] > m0) { m0 = bs[t]; v0 = sg[t]; i0 = t; }
            float m1 = -INFINITY, v1 = 0.f; int i1 = 0;
#pragma unroll
            for (int t = 0; t < 4; ++t) if (t != i0 && bs[t] > m1) { m1 = bs[t]; v1 = sg[t]; i1 = t; }
            float bestg = m0 + m1, s0 = v0, s1 = v1; int epk = (4 * qg + i0) | ((4 * qg + i1) << 8);
            { const bool oddrow = (qg & 1) != 0;
              auto x0_ = __builtin_amdgcn_permlane16_swap(__float_as_uint(bestg), __float_as_uint(bestg), false, false); auto x1_ = __builtin_amdgcn_permlane16_swap(__float_as_uint(s0), __float_as_uint(s0), false, false);
              auto x2_ = __builtin_amdgcn_permlane16_swap(__float_as_uint(s1), __float_as_uint(s1), false, false); auto x3_ = __builtin_amdgcn_permlane16_swap((unsigned)epk, (unsigned)epk, false, false);
              const float og = __uint_as_float(oddrow ? x0_[0] : x0_[1]), o0 = __uint_as_float(oddrow ? x1_[0] : x1_[1]), o1 = __uint_as_float(oddrow ? x2_[0] : x2_[1]); const int oe = (int)(oddrow ? x3_[0] : x3_[1]);
              const bool take = (og > bestg) || (og == bestg && (qg & 1));
              if (take) { bestg = og; s0 = o0; s1 = o1; epk = oe; } }
            { auto r0_ = __builtin_amdgcn_permlane32_swap(__float_as_uint(bestg), __float_as_uint(bestg), false, false);
              auto r1_ = __builtin_amdgcn_permlane32_swap(__float_as_uint(s0), __float_as_uint(s0), false, false);
              auto r2_ = __builtin_amdgcn_permlane32_swap(__float_as_uint(s1), __float_as_uint(s1), false, false);
              auto r3_ = __builtin_amdgcn_permlane32_swap((unsigned)epk, (unsigned)epk, false, false);
              const float gl = __uint_as_float(r0_[0]), gu = __uint_as_float(r0_[1]); const bool up = gu > gl;
              bestg = up ? gu : gl; s0 = __uint_as_float(up ? r1_[1] : r1_[0]); s1 = __uint_as_float(up ? r2_[1] : r2_[0]); epk = (int)(up ? r3_[1] : r3_[0]); }
            const int e0 = epk & 255, e1 = (epk >> 8) & 255;
            if (F.lane == 0) { const float inv = __builtin_amdgcn_rcpf(s0 + s1); toke[row] = e0 | (e1 << 8); tokw[row * 2] = s0 * inv; tokw[row * 2 + 1] = s1 * inv;
                __hip_atomic_fetch_add((LAS unsigned*)(F.MISC + 16 + e0), 1u, __ATOMIC_RELAXED, __HIP_MEMORY_SCOPE_WORKGROUP); __hip_atomic_fetch_add((LAS unsigned*)(F.MISC + 16 + e1), 1u, __ATOMIC_RELAXED, __HIP_MEMORY_SCOPE_WORKGROUP); }
        }
    }
#undef LN1_LDX
    __syncthreads();
    if (F.tid < 16) bcnt[F.vcu * 16 + F.tid] = (int)F.MISC[16 + F.tid];
}

__device__ __forceinline__ void ph_dispatch(Frame F, int Mr) {
    { int t_ = threadIdx.x; asm volatile("" : "+v"(t_)); F.tid = t_; F.lane = t_ & 63; fresh_in(F); }
    const int* bcnt = (const int*)(F.ws + WS_BCNT); const int* toke = (const int*)(F.ws + WS_TOKE); int* tokp = (int*)(F.ws + WS_TOKP); int* meta = (int*)(F.ws + WS_META);
    const bf16* H2 = (const bf16*)(F.ws + WS_HL); bf16* XG = (bf16*)(F.ws + WS_XG);
    LAS int* ip = (LAS int*)F.lds;
    const int per = (F.G + 31) / 32;
    { const int e = F.tid & 15, grp = F.tid >> 4; int sa = 0, sb = 0;
      for (int k = 0; k < per; ++k) { const int blk = grp * per + k; if (blk < F.G) { const int cnt = bcnt[blk * 16 + e]; sa += cnt; if (blk < F.vcu) sb += cnt; } }
      ip[grp * 16 + e] = sa; ip[512 + grp * 16 + e] = sb; }
    __syncthreads();
    if (F.tid < 16) { int sa = 0, sb = 0;
        for (int g = 0; g < 32; ++g) { sa += ip[g * 16 + F.tid]; sb += ip[512 + g * 16 + F.tid]; }
        ip[1024 + F.tid] = sa; ip[1040 + F.tid] = sb; }
    __syncthreads();
    if (F.tid == 0) { int acc = 0;
        for (int e = 0; e < 16; ++e) { ip[1056 + e] = acc; acc += ((ip[1024 + e] + 255) >> 8) << 8; }
        ip[1056 + 16] = acc; }
    __syncthreads();
    if (F.vcu == 0 && F.tid < 17) meta[F.tid] = ip[1056 + F.tid] >> 8;
    const int n0 = F.vcu * NWAVES * F.rpw, n1 = min(n0 + NWAVES * F.rpw, Mr);
    int* rowl = (int*)(F.ws + WS_ROWL);
    if (F.wave == 0) {
        int run[16];
#pragma unroll
        for (int e = 0; e < 16; ++e) run[e] = ip[1056 + e] + ip[1040 + e];
        for (int t0 = n0; t0 < n1; t0 += 64) {
            const int tok = t0 + F.lane; const bool valid = tok < n1; const int ee = valid ? toke[tok] : 0xffff; const int e0 = ee & 255, e1 = (ee >> 8) & 255;
            int p0 = 0, p1 = 0; const unsigned long long lt = (1ull << F.lane) - 1ull;
#pragma unroll
            for (int e = 0; e < 16; ++e) { const unsigned long long m0 = __ballot(valid && e0 == e), m1 = __ballot(valid && e1 == e);
                if (e0 == e) p0 = run[e] + __popcll(m0 & lt);
                if (e1 == e) p1 = run[e] + __popcll(m0) + __popcll(m1 & lt);
                run[e] += __popcll(m0) + __popcll(m1); }
            if (valid) { tokp[tok * 2] = p0; tokp[tok * 2 + 1] = p1; rowl[p0] = tok; rowl[p1] = tok; }
        }
    }
    __syncthreads();
    {
        const int e = F.vcu & 15, part = F.vcu >> 4, nparts = (F.G + 15) >> 4;
        const int pr0 = ip[1056 + e] + ip[1024 + e], pr1 = ip[1056 + e + 1];
        int stride = nparts * NWAVES * 64; asm volatile("" : "+s"(stride));
        for (int p = pr0 + part * (NWAVES * 64) + F.tid; p < pr1; p += stride) rowl[p] = 0;
    }
}

__device__ __forceinline__ void ph_ln2(Frame F, int li, int Mr) {
    { int t_ = threadIdx.x; asm volatile("" : "+v"(t_)); F.tid = t_; F.lane = t_ & 63; fresh_in(F); }
    const float* mod = (const float*)(F.ws + WS_MOD);
    const bf16* Y = (const bf16*)(F.ws + WS_XG); bf16* HL = (bf16*)(F.ws + WS_HL);
    const float* tokw = (const float*)(F.ws + WS_TOKW); const int* tokp = (const int*)(F.ws + WS_TOKP);
    bf16* xb = (bf16*)(F.ws + WS_XB); static_assert(WS_XC == WS_XB + (size_t)LROWS * DM * 2, "context rows follow the latent rows");
    f32x4 lg[4], lb[4]; ld_f32(F.in[15] + li * DM, F.lane, lg); ld_f32(F.in[16] + li * DM, F.lane, lb);
    const int r0 = F.gw * F.rpw, r1 = min(r0 + F.rpw, Mr);
    const bool last = li == DEPTH - 1;
    int bcur = -1; f32x4 g2[4], sc1[4], sh1[4]; u32x2 nv[4], ny0[4], ny1[4];
    if (r0 < r1) { const int q0 = tokp[r0 * 2], q1 = tokp[r0 * 2 + 1];
        { const bf16* xs_ = xb + (size_t)r0 * DM;
#pragma unroll
          for (int j = 0; j < 4; ++j) nv[j] = ((const GAS u32x2*)xs_)[64 * j + F.lane]; }
#pragma unroll
        for (int j = 0; j < 4; ++j) { ny0[j] = ((const GAS u32x2*)(Y + (size_t)q0 * DM))[64 * j + F.lane]; ny1[j] = ((const GAS u32x2*)(Y + (size_t)q1 * DM))[64 * j + F.lane]; } }
    for (int row = r0; row < r1; ++row) {
        const int b = row < LROWS ? row >> 11 : 16;
        if (b != bcur) { bcur = b; const float* mb = mod + ((size_t)li * 17 + b) * 6144; ld_f32(mb + 5120, F.lane, g2);
            if (!last) { const float* mn = mod + ((size_t)(li + 1) * 17 + b) * 6144; ld_f32(mn, F.lane, sh1); ld_f32(mn + 1024, F.lane, sc1);
#pragma unroll
                for (int j = 0; j < 4; ++j) sc1[j] = sc1[j] + 1.0f; } }
        bf16* xp = xb + (size_t)row * DM;
        const float w0 = tokw[row * 2], w1 = tokw[row * 2 + 1];
        f32x4 v[4];
#pragma unroll
        for (int j = 0; j < 4; ++j) { const f32x4 y0 = (f32x4){bflo(ny0[j].x), bfhi(ny0[j].x), bflo(ny0[j].y), bfhi(ny0[j].y)}, y1 = (f32x4){bflo(ny1[j].x), bfhi(ny1[j].x), bflo(ny1[j].y), bfhi(ny1[j].y)};
            v[j] = (f32x4){bflo(nv[j].x), bfhi(nv[j].x), bflo(nv[j].y), bfhi(nv[j].y)} * DN_ALPHA + g2[j] * (y0 * w0 + y1 * w1); }
        if (row + 1 < r1) { const int rn = row + 1; const int q0 = tokp[rn * 2], q1 = tokp[rn * 2 + 1];
            { const bf16* xs_ = xb + (size_t)rn * DM;
#pragma unroll
              for (int j = 0; j < 4; ++j) nv[j] = ((const GAS u32x2*)xs_)[64 * j + F.lane]; }
#pragma unroll
            for (int j = 0; j < 4; ++j) { ny0[j] = ((const GAS u32x2*)(Y + (size_t)q0 * DM))[64 * j + F.lane]; ny1[j] = ((const GAS u32x2*)(Y + (size_t)q1 * DM))[64 * j + F.lane]; } }
        ln_core(v);
#pragma unroll
        for (int j = 0; j < 4; ++j) v[j] = v[j] * lg[j] + lb[j];
        if (last) st_f32(F.out + (size_t)row * DM, F.lane, v); else st_bf16(xp, F.lane, v);
        if (!last) {
#pragma unroll
            for (int j = 0; j < 4; ++j) v[j] = v[j] * sc1[j] + sh1[j];
            st_bf16(HL + (size_t)row * DM, F.lane, v);
        }
    }
}

__global__ void __launch_bounds__(NWAVES * 64, 2) fwd(Args args) {
    extern __shared__ __attribute__((aligned(16))) unsigned char lds[];
    Frame F;
    F.lds = (LAS unsigned char*)lds; F.MISC = (volatile LAS unsigned*)(F.lds + MISC_OFF);
    F.tid = 0; F.lane = 0; F.wave = __builtin_amdgcn_readfirstlane((int)threadIdx.x >> 6);
    F.G = gridDim.x; { const int bx = blockIdx.x; F.vcu = (F.G % 8 == 0) ? (bx % 8) * (F.G / 8) + bx / 8 : bx; }
    F.gw = F.vcu * NWAVES + F.wave; F.NGW = F.G * NWAVES; F.rpw = (MROWS + F.NGW - 1) / F.NGW;
    fresh_in(F); F.out = args.out; F.ws = args.ws;
    for (int u = threadIdx.x; u < (LDS_BYTES - MISC_OFF) / 4; u += NWAVES * 64) F.MISC[u] = 0u;
    __syncthreads();
    XcdBarrier bar; bar.bar = (unsigned*)(args.ws + WS_CTL) + CW_BAR; bar.x = 0; bar.st = nullptr;
    if (!MK_PER_PHASE) bar = xcd_barrier_post((unsigned*)(args.ws + WS_CTL) + CW_BAR, F.MISC);
    const int lo = args.ph_lo, hi = args.ph_hi;
#ifndef PHMASK
#define PHMASK 0xFFFF
#endif
#define PE(n) (((PHMASK) >> (n)) & 1)
#define IN(k) (lo <= (k) && (k) < hi)
#define SEAM(k) do { if (!MK_PER_PHASE && IN(k) && IN((k) + 1)) xcd_barrier(bar); } while (0)

    if (PE(0) && IN(0)) { ph_prologue(F); SEAM(0); }
    if (PE(1) && IN(1)) { ph_hl0(F); SEAM(1); }

    bf16* HL = (bf16*)(args.ws + WS_HL); bf16* QB = (bf16*)(args.ws + WS_Q); bf16* KB = (bf16*)(args.ws + WS_K); bf16* VB = (bf16*)(args.ws + WS_V);
    bf16* AL = (bf16*)(args.ws + WS_AL); bf16* XG = (bf16*)(args.ws + WS_XG);
    const float* rope = (const float*)(args.ws + WS_ROPE);

    for (int li = 0; li < DEPTH; ++li) {
        const int pb = 2 + 8 * li; const bool typeB = (li & 1) != 0, last = li == DEPTH - 1; const int j = li >> 1;
        const int Mr = last ? LROWS : MROWS;
        if (PE(2) && IN(pb + 0)) {
            const bf16* W = typeB ? (const bf16*)(args.ws + WS_WQKVB) + (size_t)j * 3072 * 1024 : (const bf16*)(args.ws + WS_WQKVA) + (size_t)j * 1536 * 1024;
            const int N = typeB ? 3072 : 1536;
            pg8::Gemm g{HL, W, MROWS, N, DM, nullptr, nullptr}; pg8::StaticOrder S; S.init(MROWS, N, F.G, (int)blockIdx.x);
            pg8::EpiQKV E{QB, KB, VB, typeB ? 1024 : 256, typeB ? 4 : 1, rope, QSCALE};
            pg8::gemm_phase<pg8::EpiQKV, pg8::StaticOrder, true, true>(F.lds, g, S, E);
            if (li == 0) {
                const int nu = (MROWS / 256) * (N / 256), c = (int)blockIdx.x, busy = nu % F.G;
                if (busy > 0) { if (c >= busy) convert_experts(F, 0, (c - busy) * NWAVES + F.wave, (F.G - busy) * NWAVES); }
                else convert_experts(F, 0, F.gw, F.NGW);
            }
            SEAM(pb + 0);
        }
        if (IN(pb + 1)) {
            fresh_in(F);
            if (PE(3) && !typeB) {
                const int U = last ? 2048 : 2304;
                att::phase_A((LAS char*)F.lds, QB, KB, VB, QB, F.in[8] + j * 16, F.vcu, F.G, U);
            } else if (PE(4) && typeB) {
                const float lam_init = 0.8f - 0.6f * expf(-0.3f * (float)li);
                const float* lp = F.in[11] + j * 256;
                int ln_ = threadIdx.x; asm volatile("" : "+v"(ln_)); ln_ &= 63;
                const float d1 = wave_sum(lp[ln_] * lp[64 + ln_]), d2 = wave_sum(lp[128 + ln_] * lp[192 + ln_]);
                const float lam = expf(d1) - expf(d2) + lam_init;
                const int U = last ? 2048 : 2304;
                for (int L = F.vcu; L < U; L += F.G) {
                    int pair, qb; if (L < 2048) { pair = L >> 4; qb = L & 15; } else { pair = (L - 2048) >> 1; qb = 16 + ((L - 2048) & 1); }
                    att::unit_B((LAS char*)F.lds, pair >> 3, pair & 7, qb, QB, KB, VB, QB, lam, 1.0f - lam_init, F.in[12] + j * 128);
                }
            }
            SEAM(pb + 1);
        }
        if (PE(5) && IN(pb + 2)) {
            const bf16* W = typeB ? (const bf16*)(args.ws + WS_WOB) + (size_t)j * 1024 * 1024 : (const bf16*)(args.ws + WS_WOA) + (size_t)j * 1024 * 1024;
            pg8::Gemm g{QB, W, Mr, DM, DM, nullptr, nullptr}; pg8::StaticOrder S; S.init(Mr, DM, F.G, (int)blockIdx.x);
            pg8::EpiStore E{AL, DM};
            pg8::gemm_phase<pg8::EpiStore, pg8::StaticOrder, true, true>(F.lds, g, S, E);
            {
                const int nu = (Mr / 256) * 4, c = (int)blockIdx.x, busy = nu - 2 * F.G;
                if (!last && busy > 0 && busy < F.G) { if (c >= busy) convert_experts(F, li + 1, (c - busy) * NWAVES + F.wave, (F.G - busy) * NWAVES); }
                else if (!last) convert_experts(F, li + 1, F.gw, F.NGW);
            }
            SEAM(pb + 2);
        }
        if (PE(6) && IN(pb + 3)) { ph_ln1(F, li, Mr); SEAM(pb + 3); }
        if (PE(7) && IN(pb + 4)) { ph_dispatch(F, Mr); SEAM(pb + 4); }
        if (PE(8) && IN(pb + 5)) {
            const int* meta = (const int*)(args.ws + WS_META);
            { int t_ = threadIdx.x; asm volatile("" : "+v"(t_)); if (t_ < 17) F.MISC[32 + t_] = (unsigned)meta[t_]; }
            __syncthreads();
            pg8::Gemm g{HL, (const bf16*)(args.ws + WS_WGU) + (size_t)li * 16 * 1024 * 1024, 0, 1024, DM, (const int*)(args.ws + WS_ROWL), (LAS int*)(F.lds + ROWTAB_OFF)};
            pg8::GroupedOrder S; S.init((const LAS int*)(F.MISC + 32), F.G, (int)blockIdx.x);
            pg8::EpiGateUp E{AL};
            pg8::gemm_phase<pg8::EpiGateUp, pg8::GroupedOrder, true, true, true>(F.lds, g, S, E);
            SEAM(pb + 5);
        }
        if (PE(9) && IN(pb + 6)) {
            const int* meta = (const int*)(args.ws + WS_META);
            { int t_ = threadIdx.x; asm volatile("" : "+v"(t_)); if (t_ < 17) F.MISC[32 + t_] = (unsigned)meta[t_]; }
            __syncthreads();
            pg8::Gemm g{AL, (const bf16*)(args.ws + WS_WDN) + (size_t)li * 16 * 1024 * 512, 0, 1024, 512, nullptr, nullptr};
            pg8::GroupedOrder S; S.init((const LAS int*)(F.MISC + 32), F.G, (int)blockIdx.x);
            pg8::EpiStore E{XG, DM};
            pg8::gemm_phase<pg8::EpiStore, pg8::GroupedOrder, true, true>(F.lds, g, S, E);
            SEAM(pb + 6);
        }
        if (PE(10) && IN(pb + 7)) { ph_ln2(F, li, Mr); SEAM(pb + 7); }
    }
#undef IN
#undef SEAM
}

extern "C" void kernel_launch(void* const* d_in, const int* in_sizes, int n_in, void* d_out, int out_size, void* d_ws, size_t ws_size, hipStream_t stream) {
    static int grid = 0;
    if (grid == 0) {
        if (n_in != 22 || out_size != LROWS * DM || ws_size < WS_END) { fprintf(stderr, "kernel_launch: unexpected shapes (n_in %d, out %d, ws %zu < %zu); nothing launched\n", n_in, out_size, ws_size, (size_t)WS_END); grid = -1; return; }
        int dev = 0, cus = 0, per_cu = 0;
        if (hipGetDevice(&dev) != hipSuccess || hipDeviceGetAttribute(&cus, hipDeviceAttributeMultiprocessorCount, dev) != hipSuccess) { grid = -1; return; }
        if (hipFuncSetAttribute((const void*)fwd, hipFuncAttributeMaxDynamicSharedMemorySize, LDS_BYTES) != hipSuccess) { fprintf(stderr, "kernel_launch: hipFuncSetAttribute failed\n"); grid = -1; return; }
        if (hipOccupancyMaxActiveBlocksPerMultiprocessor(&per_cu, (const void*)fwd, NWAVES * 64, LDS_BYTES) != hipSuccess || per_cu < 1) { fprintf(stderr, "kernel_launch: occupancy query reports %d\n", per_cu); }
        (void)hipGetLastError();
        grid = cus;
    }
    if (grid < 0) return;
    (void)hipMemsetAsync((char*)d_ws + WS_CTL, 0, CTL_ZERO_BYTES, stream);
    Args a{};
    for (int i = 0; i < 22; ++i) a.in[i] = (const float*)d_in[i];
    a.out = (float*)d_out; a.ws = (unsigned char*)d_ws;
#if MK_PER_PHASE
    for (int p = 0; p < NPHASE; ++p) { a.ph_lo = p; a.ph_hi = p + 1; hipLaunchKernelGGL(fwd, dim3(grid), dim3(NWAVES * 64), LDS_BYTES, stream, a); }
#else
    a.ph_lo = 0; a.ph_hi = NPHASE; hipLaunchKernelGGL(fwd, dim3(grid), dim3(NWAVES * 64), LDS_BYTES, stream, a);
#endif
}
```

```cpp
#include <hip/hip_runtime.h>
#include <cstdio>
#include <cstdint>

namespace pg8 {
#define PG8_LAS __attribute__((address_space(3)))
typedef unsigned short bf16_t;
typedef short bf16x8 __attribute__((ext_vector_type(8)));
typedef float f32x4 __attribute__((ext_vector_type(4)));
typedef unsigned u32x4 __attribute__((ext_vector_type(4)));
typedef unsigned u32x2 __attribute__((ext_vector_type(2)));
constexpr int BM = 256, BK = 64, HALF = 128, HTB = HALF * BK * 2  , STAGE_BYTES = 8 * HTB, NXCD = 8, WGM = 8;

__host__ __device__ __forceinline__ int lds_byte(int r, int c) { const int st = (r >> 4) * 2 + (c >> 5), rr = r & 15, cc = c & 31, ob = rr * 64 + cc * 2; return st * 1024 + (ob ^ (((ob >> 9) & 1) << 5)); }
__host__ __device__ __forceinline__ void stage_rc(int b, int& R, int& C) { const int st = b / 1024, sb = b % 1024, swz = sb ^ (((sb >> 9) & 1) << 5); R = (st >> 1) * 16 + swz / 64; C = (st & 1) * 32 + (swz % 64) / 2; }
__host__ __device__ __forceinline__ int perm32(int rho) { const int n = rho >> 4, i = rho & 15; return 8 * (i >> 2) + 4 * n + (i & 3); }

struct Unit { int pm, pn, pb; };
struct Gemm { const bf16_t* A; const bf16_t* Bt; int M, N, K; const int* rowlist; PG8_LAS int* rowtab; };

struct StaticOrder {
    int nM, nN, nwg, G, c;
    __host__ __device__ void init(int M, int N, int G_, int c_) { nM = M / BM; nN = N / BM; nwg = nM * nN; G = G_; c = c_; }
    __host__ __device__ bool next(int i, Unit& u) const {
        const long L = (long)i * G + c; if (L >= nwg) return false;
        int wgid = (int)L; { const int q = nwg / NXCD, r = nwg % NXCD, xcd = wgid % NXCD, off = wgid / NXCD; wgid = (xcd < r ? xcd * (q + 1) : r * (q + 1) + (xcd - r) * q) + off; }
        const int nig = WGM * nN, gid = wgid / nig, fm = gid * WGM, gsz = (nM - fm) < WGM ? (nM - fm) : WGM;
        u.pm = fm + ((wgid % nig) % gsz); u.pn = (wgid % nig) / gsz; u.pb = u.pn; return true;
    }
    __device__ __forceinline__ void a_ready(const Unit&) const {}
    __device__ __forceinline__ void done(const Unit&) const {}
};
struct GroupedOrder {
    const PG8_LAS int* tb; int nwg, G, c;
    __device__ __forceinline__ void init(const PG8_LAS int* tb_, int G_, int c_) { tb = tb_; nwg = tb_[16] * 4; G = G_; c = c_; }
    __device__ __forceinline__ bool next(int i, Unit& u) const {
        const long L = (long)i * G + c; if (L >= nwg) return false;
        int wgid = (int)L; { const int q = nwg / NXCD, r = nwg % NXCD, xcd = wgid % NXCD, off = wgid / NXCD; wgid = (xcd < r ? xcd * (q + 1) : r * (q + 1) + (xcd - r) * q) + off; }
        u.pm = wgid >> 2; u.pn = wgid & 3; int e = 0;
#pragma unroll
        for (int j = 1; j < 16; ++j) e += (tb[j] <= u.pm) ? 1 : 0;
        u.pb = e * 4 + u.pn; return true;
    }
    __device__ __forceinline__ void a_ready(const Unit&) const {}
    __device__ __forceinline__ void done(const Unit&) const {}
};

__device__ __forceinline__ unsigned cvt_pk_bf16(float lo, float hi) { unsigned r; asm volatile("v_cvt_pk_bf16_f32 %0, %1, %2" : "=v"(r) : "v"(lo), "v"(hi)); return r; }

struct EpiStore {
    static constexpr bool PERM = true, AFTER_DRAIN = false;
    bf16_t* O; int ldc;
    __device__ __forceinline__ void operator()(f32x4 (&acc)[2][2][4][2], const Unit& u, int wr, int wc, int fr, int fq) const {
        const int row0 = u.pm * BM + wr * 64 + fr, col0 = u.pn * BM + wc * 32 + 8 * fq;
#pragma unroll
        for (int ai = 0; ai < 2; ++ai)
#pragma unroll
            for (int m = 0; m < 4; ++m) { bf16_t* rowp = O + (size_t)(row0 + ai * HALF + m * 16) * ldc + col0;
#pragma unroll
                for (int bj = 0; bj < 2; ++bj) { const f32x4 v0 = acc[ai][bj][m][0], v1 = acc[ai][bj][m][1];
                    u32x4 w; w.x = cvt_pk_bf16(v0[0], v0[1]); w.y = cvt_pk_bf16(v0[2], v0[3]); w.z = cvt_pk_bf16(v1[0], v1[1]); w.w = cvt_pk_bf16(v1[2], v1[3]);
                    *(u32x4*)(rowp + bj * HALF) = w; acc[ai][bj][m][0] = (f32x4){0.f, 0.f, 0.f, 0.f}; acc[ai][bj][m][1] = (f32x4){0.f, 0.f, 0.f, 0.f}; } }
    }
};
struct EpiGateUp {
    static constexpr bool PERM = true, AFTER_DRAIN = false;
    bf16_t* O;
    __device__ __forceinline__ void operator()(f32x4 (&acc)[2][2][4][2], const Unit& u, int wr, int wc, int fr, int fq) const {
        const int row0 = u.pm * BM + wr * 64 + fr, col0 = (u.pn * BM + wc * 32 + 8 * fq) >> 1;
#pragma unroll
        for (int ai = 0; ai < 2; ++ai)
#pragma unroll
            for (int m = 0; m < 4; ++m) { bf16_t* rowp = O + (size_t)(row0 + ai * HALF + m * 16) * 512 + col0;
#pragma unroll
                for (int bj = 0; bj < 2; ++bj) { const f32x4 g = acc[ai][bj][m][0], up = acc[ai][bj][m][1]; f32x4 a;
#pragma unroll
                    for (int e = 0; e < 4; ++e) { const float sg = __builtin_amdgcn_rcpf(1.0f + __builtin_amdgcn_exp2f(-1.4426950408889634f * g[e])); a[e] = g[e] * sg * up[e]; }
                    u32x2 w; w.x = cvt_pk_bf16(a[0], a[1]); w.y = cvt_pk_bf16(a[2], a[3]);
                    *(u32x2*)(rowp + bj * (HALF / 2)) = w; acc[ai][bj][m][0] = (f32x4){0.f, 0.f, 0.f, 0.f}; acc[ai][bj][m][1] = (f32x4){0.f, 0.f, 0.f, 0.f}; } }
    }
};
struct EpiQKV {
    static constexpr bool PERM = true, AFTER_DRAIN = false;
    bf16_t *Q, *K, *V; int kvp, nk; const float* rope; float qscale;
    __device__ __forceinline__ void operator()(f32x4 (&acc)[2][2][4][2], const Unit& u, int wr, int wc, int fr, int fq) const {
        bf16_t* base; int ldc, colt; bool rp; float sc;
        if (u.pn < 4) { base = Q; ldc = 1024; colt = u.pn * BM; rp = true; sc = qscale; }
        else if (u.pn < 4 + nk) { base = K; ldc = kvp; colt = (u.pn - 4) * BM; rp = true; sc = 1.0f; }
        else { base = V; ldc = kvp; colt = (u.pn - 4 - nk) * BM; rp = false; sc = 1.0f; }
        rp = rp && (u.pm < 128);
        const int row0 = u.pm * BM + wr * 64 + fr, col0 = colt + wc * 32 + 8 * fq;
        const int pi0 = (col0 & 63) >> 1; const bool rowax = (wc & 1) == 0;
        f32x4 t0[4], t1[4];
#pragma unroll
        for (int i = 0; i < 4; ++i) { t0[i] = (f32x4){1.f, 0.f, 1.f, 0.f}; t1[i] = t0[i]; }
        if (rp) {
            if (rowax) {
#pragma unroll
                for (int ai = 0; ai < 2; ++ai) { const int pos = ((u.pm * BM + ai * HALF + wr * 64) & 2047) & ~63; const float* tp = rope + ((size_t)pos * 32 + pi0) * 2; t0[ai] = *(const f32x4*)tp; t1[ai] = *(const f32x4*)(tp + 4); }
            } else {
#pragma unroll
                for (int m = 0; m < 4; ++m) { const int pos = m * 16 + fr; const float* tp = rope + ((size_t)pos * 32 + pi0) * 2; t0[m] = *(const f32x4*)tp; t1[m] = *(const f32x4*)(tp + 4); }
            }
            asm volatile("" : "+v"(t0[0]), "+v"(t0[1]), "+v"(t0[2]), "+v"(t0[3]), "+v"(t1[0]), "+v"(t1[1]), "+v"(t1[2]), "+v"(t1[3]));
        }
#pragma unroll
        for (int ai = 0; ai < 2; ++ai)
#pragma unroll
            for (int m = 0; m < 4; ++m) { const int row = row0 + ai * HALF + m * 16; bf16_t* rowp = base + (size_t)row * ldc + col0;
                const f32x4 c0 = rowax ? t0[ai] : t0[m], c1 = rowax ? t1[ai] : t1[m];
#pragma unroll
                for (int bj = 0; bj < 2; ++bj) { f32x4 v0 = acc[ai][bj][m][0], v1 = acc[ai][bj][m][1];
                    if (rp) { f32x4 a, b;
                        a[0] = v0[0] * c0[0] - v0[1] * c0[1]; a[1] = v0[1] * c0[0] + v0[0] * c0[1]; a[2] = v0[2] * c0[2] - v0[3] * c0[3]; a[3] = v0[3] * c0[2] + v0[2] * c0[3];
                        b[0] = v1[0] * c1[0] - v1[1] * c1[1]; b[1] = v1[1] * c1[0] + v1[0] * c1[1]; b[2] = v1[2] * c1[2] - v1[3] * c1[3]; b[3] = v1[3] * c1[2] + v1[2] * c1[3];
                        v0 = a; v1 = b; }
                    v0 = v0 * sc; v1 = v1 * sc;
                    u32x4 w; w.x = cvt_pk_bf16(v0[0], v0[1]); w.y = cvt_pk_bf16(v0[2], v0[3]); w.z = cvt_pk_bf16(v1[0], v1[1]); w.w = cvt_pk_bf16(v1[2], v1[3]);
                    *(u32x4*)(rowp + bj * HALF) = w; acc[ai][bj][m][0] = (f32x4){0.f, 0.f, 0.f, 0.f}; acc[ai][bj][m][1] = (f32x4){0.f, 0.f, 0.f, 0.f}; } }
    }
};

template <class Epi, class Sched, bool ALIGN_EPI = false, bool SP2 = false, bool GATHER = false>
__device__ __forceinline__ void gemm_phase(PG8_LAS unsigned char* lds, const Gemm g, const Sched& S, const Epi& E) {
    int tid_ = threadIdx.x; asm volatile("" : "+v"(tid_));
    const int tid = tid_, wid = __builtin_amdgcn_readfirstlane(tid >> 6), lane = tid & 63, wr = wid >> 2, wc = wid & 3, fr = lane & 15, fq = lane >> 4;
    const int K = g.K, nt = K / BK;
    unsigned voffA[2], voffB[2];
#pragma unroll
    for (int i = 0; i < 2; ++i) { int R, C; stage_rc(tid * 16 + i * 8192, R, C); const int Rb = Epi::PERM ? ((R & ~31) + perm32(R & 31)) : R;
        voffA[i] = (unsigned)(R * K + C) * 2u; voffB[i] = (unsigned)(Rb * K + C) * 2u; }
    unsigned vc[2] = {0u, 0u}, vn[2] = {0u, 0u}, cofs[2] = {0u, 0u}; const size_t rowb = (size_t)K * 2;
    if constexpr (GATHER) {
#pragma unroll
        for (int i = 0; i < 2; ++i) { int R, C; stage_rc(tid * 16 + i * 8192, R, C); cofs[i] = (unsigned)C * 2u; }
        Unit u_;
        for (int i = 0; S.next(i, u_); ++i) if (tid < 256) g.rowtab[i * 256 + tid] = g.rowlist[u_.pm * 256 + tid];
        asm volatile("s_waitcnt vmcnt(0) lgkmcnt(0)" ::: "memory"); __builtin_amdgcn_s_barrier(); asm volatile("" ::: "memory");
    }
#define PG8_LDROWS(slot, dst) do { int R0_, C0_, R1_, C1_; stage_rc(tid * 16, R0_, C0_); stage_rc(tid * 16 + 8192, R1_, C1_); \
        _Pragma("unroll") for (int h_ = 0; h_ < 2; ++h_) dst[h_] = (unsigned)g.rowtab[(slot) * 256 + h_ * 128 + R0_] | ((unsigned)g.rowtab[(slot) * 256 + h_ * 128 + R1_] << 16); } while (0)
    const size_t kstep = (size_t)(BK * 2);
    const size_t hstep = (size_t)HALF * K * 2;
    const size_t tstep = 2 * hstep;
    const unsigned ldsw = (unsigned)wid * 1024u;
    const int aoff = lds_byte(wr * 64 + fr, fq * 8), boff = lds_byte(wc * 32 + fr, fq * 8);
#define PG8_SA(b, h) (((b) * 2 + (h)) * HTB)
#define PG8_SB(b, h) ((4 + (b) * 2 + (h)) * HTB)
#define PG8_STAGE(bufoff, gbase, voff) do { _Pragma("unroll") for (int _i = 0; _i < 2; ++_i) \
        __builtin_amdgcn_global_load_lds((const unsigned*)((const char*)(gbase) + (voff)[_i]), (PG8_LAS unsigned*)(lds + (bufoff) + ldsw + _i * 8192), 16, 0, 0); } while (0)
#define PG8_STAGE_A(bufoff, abase, h, NX) do { if constexpr (GATHER) { const unsigned rp_ = (NX) ? vn[h] : vc[h]; \
        _Pragma("unroll") for (int _i = 0; _i < 2; ++_i) { const unsigned row_ = _i ? (rp_ >> 16) : (rp_ & 0xffffu); \
            __builtin_amdgcn_global_load_lds((const unsigned*)((const char*)(abase) + (size_t)row_ * rowb + cofs[_i]), (PG8_LAS unsigned*)(lds + (bufoff) + ldsw + _i * 8192), 16, 0, 0); } } \
    else { PG8_STAGE(bufoff, (abase) + ((h) ? hstep : (size_t)0), voffA); } } while (0)
#define PG8_LDA(dst, b, h) do { _Pragma("unroll") for (int m = 0; m < 4; ++m) _Pragma("unroll") for (int k = 0; k < 2; ++k) dst[m][k] = *(const PG8_LAS bf16x8*)(lds + PG8_SA(b, h) + aoff + m * 2048 + k * 1024); } while (0)
#define PG8_LDB(dst, b, h) do { _Pragma("unroll") for (int n = 0; n < 2; ++n) _Pragma("unroll") for (int k = 0; k < 2; ++k) dst[n][k] = *(const PG8_LAS bf16x8*)(lds + PG8_SB(b, h) + boff + n * 2048 + k * 1024); } while (0)
#define PG8_MMA(ai, bj, At, Bt) do { __builtin_amdgcn_s_setprio(1); _Pragma("unroll") for (int m = 0; m < 4; ++m) _Pragma("unroll") for (int n = 0; n < 2; ++n) _Pragma("unroll") for (int k = 0; k < 2; ++k) \
        acc[ai][bj][m][n] = __builtin_amdgcn_mfma_f32_16x16x32_bf16(Bt[n][k], At[m][k], acc[ai][bj][m][n], 0, 0, 0); __builtin_amdgcn_s_setprio(0); } while (0)
#define PG8_WAIT_V(n) asm volatile("s_waitcnt vmcnt(" #n ")" ::: "memory")
#define PG8_WAIT_L(n) asm volatile("s_waitcnt lgkmcnt(" #n ")" ::: "memory")
#define PG8_BAR __builtin_amdgcn_s_barrier()
#define PG8_SCHED __builtin_amdgcn_sched_barrier(0)
    Unit cur, nxt; int ui = 0;
    if (!S.next(0, cur)) return;
    f32x4 acc[2][2][4][2];
#pragma unroll
    for (int a = 0; a < 2; ++a)
#pragma unroll
        for (int b = 0; b < 2; ++b)
#pragma unroll
            for (int m = 0; m < 4; ++m)
#pragma unroll
                for (int n = 0; n < 2; ++n) acc[a][b][m][n] = (f32x4){0.f, 0.f, 0.f, 0.f};
    bf16x8 At[4][2], B0[2][2], B1[2][2];
    const char* cA = (const char*)g.A + (GATHER ? (size_t)0 : (size_t)cur.pm * tstep); const char* cB = (const char*)g.Bt + (size_t)cur.pb * tstep;
    if constexpr (GATHER) { PG8_LDROWS(0, vc); }
    S.a_ready(cur);
    if constexpr (SP2) {
        PG8_STAGE(PG8_SB(0, 0), cB, voffB); PG8_STAGE(PG8_SB(0, 1), cB + hstep, voffB); PG8_STAGE_A(PG8_SA(0, 0), cA, 0, false); PG8_STAGE_A(PG8_SA(0, 1), cA, 1, false);
        if (wr == 1) PG8_BAR;
        PG8_WAIT_V(2); PG8_BAR;
        PG8_STAGE(PG8_SB(1, 0), cB + kstep, voffB); PG8_STAGE_A(PG8_SA(1, 0), cA + kstep, 0, false); PG8_STAGE(PG8_SB(1, 1), cB + hstep + kstep, voffB);
        PG8_WAIT_V(6); PG8_BAR;
    } else {
        PG8_STAGE(PG8_SB(0, 0), cB, voffB); PG8_STAGE_A(PG8_SA(0, 0), cA, 0, false); PG8_STAGE(PG8_SB(0, 1), cB + hstep, voffB); PG8_STAGE_A(PG8_SA(0, 1), cA, 1, false);
        if (wr == 1) PG8_BAR;
        PG8_WAIT_V(4); PG8_BAR;
        PG8_STAGE(PG8_SB(1, 0), cB + kstep, voffB); PG8_STAGE_A(PG8_SA(1, 0), cA + kstep, 0, false); PG8_STAGE(PG8_SB(1, 1), cB + hstep + kstep, voffB);
        PG8_WAIT_V(6); PG8_BAR;
    }
    for (;;) {
        const bool has_next = S.next(ui + 1, nxt);
        const char* nA = (has_next && !GATHER) ? (const char*)g.A + (size_t)nxt.pm * tstep : cA;
        if constexpr (GATHER) { if (has_next) { PG8_LDROWS(ui + 1, vn); } else { vn[0] = vc[0]; vn[1] = vc[1]; } } const char* nB = has_next ? (const char*)g.Bt + (size_t)nxt.pb * tstep : cB;
        for (int t = 0; t < nt; t += 2) {
            const bool last = (t == nt - 2);
            const char* a1 = cA + (size_t)(t + 1) * kstep;
            const char* a2 = last ? nA : cA + (size_t)(t + 2) * kstep; const char* b2 = last ? nB : cB + (size_t)(t + 2) * kstep;
            const char* a3 = a2 + kstep; const char* b3 = b2 + kstep;
            if (last && has_next) S.a_ready(nxt);
            if constexpr (SP2) {
            PG8_LDB(B0, 0, 0); PG8_LDB(B1, 0, 1); PG8_SCHED; PG8_LDA(At, 0, 0); PG8_STAGE_A(PG8_SA(1, 1), a1, 1, false);
            PG8_WAIT_V(8); PG8_WAIT_L(0); PG8_BAR; PG8_MMA(0, 0, At, B0); PG8_MMA(0, 1, At, B1); PG8_BAR; PG8_SCHED;
            PG8_LDA(At, 0, 1); PG8_STAGE(PG8_SB(0, 0), b2, voffB); PG8_STAGE(PG8_SB(0, 1), b2 + hstep, voffB); PG8_STAGE_A(PG8_SA(0, 0), a2, 0, last);
            PG8_WAIT_V(8); PG8_WAIT_L(0); PG8_BAR; PG8_MMA(1, 0, At, B0); PG8_MMA(1, 1, At, B1); PG8_BAR; PG8_SCHED;
            PG8_LDB(B0, 1, 0); PG8_LDB(B1, 1, 1); PG8_SCHED; PG8_LDA(At, 1, 0); PG8_STAGE_A(PG8_SA(0, 1), a2, 1, last);
            PG8_WAIT_V(8); PG8_WAIT_L(0); PG8_BAR; PG8_MMA(0, 0, At, B0); PG8_MMA(0, 1, At, B1); PG8_BAR; PG8_SCHED;
            PG8_LDA(At, 1, 1); PG8_STAGE(PG8_SB(1, 0), b3, voffB); PG8_STAGE(PG8_SB(1, 1), b3 + hstep, voffB); PG8_STAGE_A(PG8_SA(1, 0), a3, 0, last);
            PG8_WAIT_V(8); PG8_WAIT_L(0); PG8_BAR; PG8_MMA(1, 0, At, B0); PG8_MMA(1, 1, At, B1); PG8_BAR; PG8_SCHED;
            } else {
            PG8_LDB(B0, 0, 0); PG8_SCHED; PG8_LDA(At, 0, 0); PG8_STAGE_A(PG8_SA(1, 1), a1, 1, false);
            PG8_WAIT_L(8); PG8_BAR; PG8_WAIT_L(0); PG8_MMA(0, 0, At, B0); PG8_BAR; PG8_SCHED;
            PG8_LDB(B1, 0, 1); PG8_STAGE(PG8_SB(0, 0), b2, voffB);
            PG8_BAR; PG8_WAIT_L(0); PG8_MMA(0, 1, At, B1); PG8_BAR;
            PG8_LDA(At, 0, 1); PG8_STAGE_A(PG8_SA(0, 0), a2, 0, last);
            PG8_BAR; PG8_WAIT_L(0); PG8_MMA(1, 0, At, B0); PG8_BAR; PG8_SCHED;
            PG8_STAGE(PG8_SB(0, 1), b2 + hstep, voffB);
            PG8_WAIT_V(6); PG8_BAR; PG8_MMA(1, 1, At, B1); PG8_BAR;
            PG8_LDB(B0, 1, 0); PG8_SCHED; PG8_LDA(At, 1, 0); PG8_STAGE_A(PG8_SA(0, 1), a2, 1, last);
            PG8_WAIT_L(8); PG8_BAR; PG8_WAIT_L(0); PG8_MMA(0, 0, At, B0); PG8_BAR; PG8_SCHED;
            PG8_LDB(B1, 1, 1); PG8_STAGE(PG8_SB(1, 0), b3, voffB);
            PG8_BAR; PG8_WAIT_L(0); PG8_MMA(0, 1, At, B1); PG8_BAR;
            PG8_LDA(At, 1, 1); PG8_STAGE_A(PG8_SA(1, 0), a3, 0, last);
            PG8_BAR; PG8_WAIT_L(0); PG8_MMA(1, 0, At, B0); PG8_BAR; PG8_SCHED;
            PG8_STAGE(PG8_SB(1, 1), b3 + hstep, voffB);
            PG8_WAIT_V(6); PG8_BAR; PG8_MMA(1, 1, At, B1); PG8_BAR;
            }
        }
        if constexpr (ALIGN_EPI) { if (wr == 0) PG8_BAR; }
        if constexpr (!Epi::AFTER_DRAIN) { E(acc, cur, wr, wc, fr, fq); S.done(cur); }
        if (!has_next) break;
        cur = nxt; cA = nA; cB = nB; ++ui; if constexpr (GATHER) { vc[0] = vn[0]; vc[1] = vn[1]; }
        if constexpr (ALIGN_EPI) { if (wr == 1) PG8_BAR; }
    }
    PG8_WAIT_V(0);
    if constexpr (!ALIGN_EPI) { if (wr == 0) PG8_BAR; }
    PG8_BAR;
    if constexpr (Epi::AFTER_DRAIN) { E.fused(acc, cur, wr, wc, fr, fq, lds, wid, lane); S.done(cur); }
#undef PG8_SA
#undef PG8_SB
#undef PG8_STAGE
#undef PG8_STAGE_A
#undef PG8_LDROWS
#undef PG8_LDA
#undef PG8_LDB
#undef PG8_MMA
#undef PG8_WAIT_V
#undef PG8_WAIT_L
#undef PG8_BAR
#undef PG8_SCHED
}}

namespace att {
#define ALAS __attribute__((address_space(3)))
typedef unsigned short bf16_t;
typedef short bf16x8 __attribute__((ext_vector_type(8)));
typedef short s16x4 __attribute__((ext_vector_type(4)));
typedef float f32x16 __attribute__((ext_vector_type(16)));
typedef unsigned u32x4 __attribute__((ext_vector_type(4)));
typedef float f32x2_t __attribute__((ext_vector_type(2))); typedef __bf16 bf16x2_t __attribute__((ext_vector_type(2)));
constexpr float THR = 8.0f;
constexpr int LROWS = 32768;
__device__ __forceinline__ int crow(int r, int hi) { return (r & 3) + 8 * (r >> 2) + 4 * hi; }
__device__ __forceinline__ unsigned cvtpk(float lo, float hi) { f32x2_t v = {lo, hi}; bf16x2_t b = __builtin_convertvector(v, bf16x2_t); return __builtin_bit_cast(unsigned, b); }
__device__ __forceinline__ unsigned short f2bf(float f) { unsigned u = __builtin_bit_cast(unsigned, f); return (unsigned short)((u + 0x7fffu + ((u >> 16) & 1u)) >> 16); }
typedef short v4i16_t __attribute__((ext_vector_type(4)));
__device__ __forceinline__ s16x4 vtr(const ALAS char* p) { return __builtin_bit_cast(s16x4, __builtin_amdgcn_ds_read_tr16_b64_v4i16((ALAS v4i16_t*)p)); }
template <int X> __device__ __forceinline__ float lane_xor32(float v) {
    if (X == 1) return __builtin_bit_cast(float, __builtin_amdgcn_update_dpp(0, __builtin_bit_cast(int, v), 0xB1, 0xF, 0xF, true));
    if (X == 2) return __builtin_bit_cast(float, __builtin_amdgcn_update_dpp(0, __builtin_bit_cast(int, v), 0x4E, 0xF, 0xF, true));
    return __builtin_bit_cast(float, __builtin_amdgcn_ds_swizzle(__builtin_bit_cast(int, v), (X << 10) | 0x1F));
}
template <int N> __device__ __forceinline__ float att_ror(float v) { return __builtin_bit_cast(float, __builtin_amdgcn_update_dpp(0, __builtin_bit_cast(int, v), 0x120 | N, 0xF, 0xF, true)); }
__device__ __forceinline__ float half_sum32v(float v) { v += att_ror<8>(v); v += att_ror<4>(v); v += att_ror<2>(v); v += att_ror<1>(v);
    auto rr = __builtin_amdgcn_permlane16_swap(__float_as_uint(v), __float_as_uint(v), false, false); return __uint_as_float(rr[0]) + __uint_as_float(rr[1]); }
__device__ __forceinline__ float half_sum32(float v) { v += lane_xor32<1>(v); v += lane_xor32<2>(v); v += lane_xor32<4>(v); v += lane_xor32<8>(v); v += lane_xor32<16>(v); return v; }
__device__ __forceinline__ float swapmax(float m) { auto rr = __builtin_amdgcn_permlane32_swap(__float_as_uint(m), __float_as_uint(m), false, false); return fmaxf(__uint_as_float(rr[0]), __uint_as_float(rr[1])); }
__device__ __forceinline__ float swapadd(float m) { auto rr = __builtin_amdgcn_permlane32_swap(__float_as_uint(m), __float_as_uint(m), false, false); return __uint_as_float(rr[0]) + __uint_as_float(rr[1]); }

__device__ __forceinline__ void glds16(const void* gsrc, unsigned lds_dst) {
    asm volatile("s_mov_b32 m0, %1\n\ts_nop 0\n\tglobal_load_lds_dwordx4 %0, off" :: "v"(gsrc), "s"(lds_dst) : "memory", "m0"); }
#define RFL(x) ((unsigned)__builtin_amdgcn_readfirstlane((int)(x)))
struct DmaA { const bf16_t* k; const bf16_t* v; unsigned sb; bool on;
    __device__ __forceinline__ void operator()(int i) const { if (on) { if (i == 0) glds16(k, RFL(sb)); if (i == 2) glds16(v, RFL(sb + 8192)); } } };
struct DmaB { const bf16_t* k; const bf16_t* v; unsigned sb; bool on;
    __device__ __forceinline__ void operator()(int i) const { if (on) { if (i == 0) glds16(k, RFL(sb)); if (i == 1) glds16(k + 64, RFL(sb + 8192)); if (i == 2) glds16(v, RFL(sb + 16384)); if (i == 3) glds16(v + 64, RFL(sb + 24576)); } } };
template <int DVB, class DMA>
__device__ __forceinline__ void step_y(const DMA& dma, const ALAS char* Vs, f32x16 (&o)[DVB], const u32x4 (&pw)[4], int lane, int hi) {
    const ALAS char* vp = Vs + ((lane >> 4) & 1) * 32 + (lane & 3) * 8 + (4 * hi + ((lane & 15) >> 2)) * 64;
    s16x4 va[8], vb[8];
#pragma unroll
    for (int ks = 0; ks < 4; ++ks) { va[2 * ks] = vtr(vp + ks * 1024); va[2 * ks + 1] = vtr(vp + ks * 1024 + 512); }
#pragma unroll
    for (int db = 0; db < DVB; ++db) {
        if (db + 1 < DVB) {
#pragma unroll
            for (int ks = 0; ks < 4; ++ks) { vb[2 * ks] = vtr(vp + (db + 1) * 4096 + ks * 1024); vb[2 * ks + 1] = vtr(vp + (db + 1) * 4096 + ks * 1024 + 512); }
        }
        __builtin_amdgcn_sched_barrier(0);
        __builtin_amdgcn_s_setprio(1);
#pragma unroll
        for (int ks = 0; ks < 4; ++ks) {
            const bf16x8 vf = (bf16x8){va[2 * ks][0], va[2 * ks][1], va[2 * ks][2], va[2 * ks][3], va[2 * ks + 1][0], va[2 * ks + 1][1], va[2 * ks + 1][2], va[2 * ks + 1][3]};
            o[db] = __builtin_amdgcn_mfma_f32_32x32x16_bf16(__builtin_bit_cast(bf16x8, pw[ks]), vf, o[db], 0, 0, 0);
        }
        __builtin_amdgcn_s_setprio(0);
        dma(DVB == 2 ? 2 * db : db);
        __builtin_amdgcn_sched_barrier(0);
        if (db + 1 < DVB) {
#pragma unroll
            for (int i = 0; i < 8; ++i) va[i] = vb[i];
        }
    }
}
template <bool MASK, bool PREV, int SKIP = 0, class DMA>
__device__ __forceinline__ bool step_qk(const DMA& dma, const ALAS char* Ks, const ALAS char* Vs, s16x4 (&vlo)[4], s16x4 (&vhi)[4], const bf16x8 (&qr)[4], f32x16& p0, f32x16& p1, f32x16& negm, float& mhat, float& l, ALAS float* wsf, int lane, int r32, int hi, bool first, int mrel) {
    const ALAS char* kb = Ks + r32 * 128; const int sw = (r32 >> 1) & 7;
    bf16x8 kc0[4], kc1[4];
    { const int off = ((0 + hi) ^ sw) << 4; if (SKIP != 1) kc0[0] = *(const ALAS bf16x8*)(kb + off); if (SKIP != 2) kc1[0] = *(const ALAS bf16x8*)(kb + 4096 + off); }
    __builtin_amdgcn_s_setprio(1);
#pragma unroll
    for (int d0 = 0; d0 < 4; ++d0) {
        if (d0 + 1 < 4) { const int off = ((2 * (d0 + 1) + hi) ^ sw) << 4; if (SKIP != 1) kc0[d0 + 1] = *(const ALAS bf16x8*)(kb + off); if (SKIP != 2) kc1[d0 + 1] = *(const ALAS bf16x8*)(kb + 4096 + off); }
        __builtin_amdgcn_sched_barrier(0);
        if (SKIP != 0) { if (SKIP == 2) p0 = __builtin_amdgcn_mfma_f32_32x32x16_bf16(kc0[d0], qr[d0], d0 == 0 ? negm : p0, 0, 0, 0); else p1 = __builtin_amdgcn_mfma_f32_32x32x16_bf16(kc1[d0], qr[d0], d0 == 0 ? negm : p1, 0, 0, 0); }
        else if (d0 == 0) { p0 = __builtin_amdgcn_mfma_f32_32x32x16_bf16(kc0[0], qr[0], negm, 0, 0, 0);
            asm volatile("v_mfma_f32_32x32x16_bf16 %0, %1, %2, %3" : "=&v"(p1) : "v"(kc1[0]), "v"(qr[0]), "v"(negm)); }
        else { p0 = __builtin_amdgcn_mfma_f32_32x32x16_bf16(kc0[d0], qr[d0], p0, 0, 0, 0); p1 = __builtin_amdgcn_mfma_f32_32x32x16_bf16(kc1[d0], qr[d0], p1, 0, 0, 0); }
        dma(d0);
        if (d0 == 3) __builtin_amdgcn_s_setprio(0);
    }
    if (PREV) {
        const ALAS char* vp = Vs + ((lane >> 4) & 1) * 32 + (lane & 3) * 8 + (4 * hi + ((lane & 15) >> 2)) * 64;
#pragma unroll
        for (int i = 0; i < 4; ++i) { vlo[i] = vtr(vp + i * 1024); vhi[i] = vtr(vp + i * 1024 + 512); }
    }
    if (MASK) {
#pragma unroll
        for (int r = 0; r < 16; ++r) { const int rel = mrel + crow(r, hi);
            if (SKIP != 1) if (rel < -128 || rel > 128) p0[r] = -INFINITY;
            if (SKIP != 2) if (rel + 32 < -128 || rel + 32 > 128) p1[r] = -INFINITY; }
    }
    float ma, mb;
    if (SKIP != 0) { const f32x16& q = SKIP == 1 ? p1 : p0; ma = fmaxf(fmaxf(q[0], q[1]), q[2]); mb = q[3];
#pragma unroll
        for (int r = 4; r < 16; r += 4) { ma = fmaxf(fmaxf(ma, q[r]), q[r + 1]); mb = fmaxf(fmaxf(mb, q[r + 2]), q[r + 3]); }
    } else {
    ma = fmaxf(fmaxf(p0[0], p0[1]), p1[0]); mb = fmaxf(fmaxf(p0[2], p0[3]), p1[1]);
    ma = fmaxf(fmaxf(ma, p1[2]), p1[3]);
#pragma unroll
    for (int r = 4; r < 16; r += 4) { ma = fmaxf(fmaxf(ma, p0[r]), p0[r + 1]); mb = fmaxf(fmaxf(mb, p0[r + 2]), p0[r + 3]); ma = fmaxf(fmaxf(ma, p1[r]), p1[r + 1]); mb = fmaxf(fmaxf(mb, p1[r + 2]), p1[r + 3]); }
    }
    const float mx = swapmax(fmaxf(ma, mb));
    bool resc = false;
    if (first) {
        mhat = mx;
#pragma unroll
        for (int r = 0; r < 16; ++r) { if (SKIP != 1) p0[r] -= mx; if (SKIP != 2) p1[r] -= mx; negm[r] = -mx; }
    } else if (__any(mx > THR)) {
        const float dl = fmaxf(mx, 0.f); mhat += dl;
#pragma unroll
        for (int r = 0; r < 16; ++r) { if (SKIP != 1) p0[r] -= dl; if (SKIP != 2) p1[r] -= dl; negm[r] = -mhat; }
        const float f = __builtin_amdgcn_exp2f(-dl); l *= f;
        if (hi == 0) wsf[r32] = f;
        resc = true;
    }
    return resc;
}
#define ATT_EL(e) ((e) < 16 ? p0[(e) & 15] : p1[(e) & 15])
struct NoDma { __device__ __forceinline__ void operator()(int) const {} };
#define ATT_LIVE(e) (SS == 0 || (SS == 1 ? (e) >= 16 : (e) < 16))
template <int DVB, bool DO_PV, class DMA = NoDma, int SS = 0, int PS = 0>
__device__ __forceinline__ void step_pv_sm(const ALAS char* Vs, s16x4 (&vlo)[4], s16x4 (&vhi)[4], f32x16 (&o)[DVB], const u32x4 (&pwo)[4], f32x16& p0, f32x16& p1, u32x4 (&pwn)[4], float& l, int lane, int hi, const DMA& dma = DMA()) {
    float s0 = 0.f, s1 = 0.f; unsigned pk[16];
    if (!DO_PV) {
#pragma unroll
        for (int r = 0; r < 16; ++r) { if (SS != 1) { p0[r] = __builtin_amdgcn_exp2f(p0[r]); s0 += p0[r]; } if (SS != 2) { p1[r] = __builtin_amdgcn_exp2f(p1[r]); s1 += p1[r]; } }
#pragma unroll
        for (int t = 0; t < 16; ++t) { if (ATT_LIVE(2 * t)) pk[t] = cvtpk(ATT_EL(2 * t), ATT_EL(2 * t + 1)); else pk[t] = 0u; }
    } else {
        constexpr int NM = DVB * 4, EPG = 32 / NM;
        const ALAS char* vp = Vs + ((lane >> 4) & 1) * 32 + (lane & 3) * 8 + (4 * hi + ((lane & 15) >> 2)) * 64;
        constexpr int LA = 4;
        __builtin_amdgcn_sched_barrier(0);
#pragma unroll
        for (int j = 0; j < NM; ++j) {
            const bf16x8 vf = (bf16x8){vlo[j % LA][0], vlo[j % LA][1], vlo[j % LA][2], vlo[j % LA][3], vhi[j % LA][0], vhi[j % LA][1], vhi[j % LA][2], vhi[j % LA][3]};
            if (!(PS == 1 && (j & 3) < 2) && !(PS == 2 && (j & 3) >= 2)) o[j >> 2] = __builtin_amdgcn_mfma_f32_32x32x16_bf16(__builtin_bit_cast(bf16x8, pwo[j & 3]), vf, o[j >> 2], 0, 0, 0);
#pragma unroll
            for (int u = 0; u < EPG; ++u) { const int e = j * EPG + u;
                if (!ATT_LIVE(e)) {} else if (e < 16) { p0[e & 15] = __builtin_amdgcn_exp2f(p0[e & 15]); } else { p1[e & 15] = __builtin_amdgcn_exp2f(p1[e & 15]); } }
            if (!ATT_LIVE(j * EPG)) asm volatile("" ::: "memory"); else if (j * EPG < 16) asm volatile("" : "+v"(p0) :: "memory"); else asm volatile("" : "+v"(p1) :: "memory");
            if (j + LA < NM) { vlo[j % LA] = vtr(vp + ((j + LA) >> 2) * 4096 + ((j + LA) & 3) * 1024); vhi[j % LA] = vtr(vp + ((j + LA) >> 2) * 4096 + ((j + LA) & 3) * 1024 + 512); }
            asm volatile("" ::: "memory");
            if (j > 0) {
#pragma unroll
                for (int u = 0; u < EPG; u += 2) { const int e = (j - 1) * EPG + u; if (ATT_LIVE(e)) { s0 += ATT_EL(e); s1 += ATT_EL(e + 1); pk[e >> 1] = cvtpk(ATT_EL(e), ATT_EL(e + 1)); asm volatile("" : "+v"(pk[e >> 1])); } else pk[e >> 1] = 0u; }
                asm volatile("" : "+v"(s0), "+v"(s1));
            }
            asm volatile("" : "+v"(o[j >> 2]));
            if (j == 1) dma(0); if (j == NM / 4 + 1) dma(1); if (j == NM / 2 + 1) dma(2); if (j == 3 * NM / 4 + 1) dma(3);
            __builtin_amdgcn_sched_barrier(0);
        }
#pragma unroll
        for (int u = 0; u < EPG; u += 2) { const int e = (NM - 1) * EPG + u; if (ATT_LIVE(e)) { s0 += ATT_EL(e); s1 += ATT_EL(e + 1); pk[e >> 1] = cvtpk(ATT_EL(e), ATT_EL(e + 1)); } else pk[e >> 1] = 0u; }
    }
#pragma unroll
    for (int k = 0; k < 4; ++k) pwn[k] = (u32x4){pk[4 * k], pk[4 * k + 1], pk[4 * k + 2], pk[4 * k + 3]};
    l += s0 + s1;
}
#undef ATT_EL
#undef ATT_LIVE
template <int DVB> __device__ __forceinline__ void rescale_o(f32x16 (&o)[DVB], ALAS float* wsf, int hi) {
    float fr_[16];
#pragma unroll
    for (int r = 0; r < 16; ++r) fr_[r] = wsf[crow(r, hi)];
#pragma unroll
    for (int db = 0; db < DVB; ++db)
#pragma unroll
        for (int r = 0; r < 16; ++r) o[db][r] *= fr_[r];
}
#define ATT_WAIT_BAR(N) asm volatile("s_waitcnt vmcnt(" #N ") lgkmcnt(0)\n\ts_barrier" ::: "memory")
#define ATT_BAR() asm volatile("s_waitcnt lgkmcnt(0)\n\ts_barrier" ::: "memory")

constexpr int WSF_OFF = 131072, OST_OFF = 65536;

struct ADesc { int NW, NT, nlo, wrow0, crow0, qrow0, kvh; };
__device__ __forceinline__ ADesc a_desc(int L) {
    int pair, qb; if (L < 2048) { pair = L >> 5; qb = L & 31; } else { pair = (L - 2048) >> 2; qb = 32 + ((L - 2048) & 3); }
    const int b = pair >> 2; ADesc d; d.kvh = pair & 3;
    const bool lat = qb < 32; const int p0 = lat ? qb * 64 : 0;
    d.nlo = lat ? (p0 == 0 ? 2 : (p0 == 64 ? 1 : 0)) : 0; const int nhi = lat ? (p0 == 1984 ? 2 : (p0 == 1920 ? 3 : 4)) : -1;
    d.NW = lat ? (nhi - d.nlo + 1) : 0; d.NT = d.NW + 4;
    d.wrow0 = b * 2048 + p0 - 128 + 64 * d.nlo; d.crow0 = LROWS + b * 256;
    d.qrow0 = lat ? b * 2048 + p0 : LROWS + b * 256 + (qb - 32) * 64;
    return d;
}
__device__ __forceinline__ void phase_A(ALAS char* shm, const bf16_t* Q, const bf16_t* K, const bf16_t* V, bf16_t* O, const float* sink, int first, int step, int U) {
    int tid_ = threadIdx.x; asm volatile("" : "+v"(tid_));
    const int tid = tid_, lane = tid & 63, r32 = lane & 31, hi = lane >> 5; const int wid = __builtin_amdgcn_readfirstlane(tid >> 6);
    constexpr int STG = 16384, KVP = 256;
    if (first >= U) return;
    const int g = wid & 3, half = wid >> 2;
    const bf16_t* klane = K + (size_t)(8 * wid + (lane >> 3)) * KVP + (((lane & 7) ^ ((wid & 1) * 4 + (lane >> 4))) << 3);
    const bf16_t* vlane = V + (size_t)(16 * (wid & 3) + (lane >> 2)) * KVP + (wid >> 2) * 32 + (lane & 3) * 8;
    const unsigned dst0 = (unsigned)(uintptr_t)shm + wid * 1024;
    ALAS float* wsf = (ALAS float*)(shm + WSF_OFF) + wid * 64;
#define A_ROWOF(d, n) ((n) < (d).NW ? (d).wrow0 + 64 * (n) : (d).crow0 + 64 * ((n) - (d).NW))
#define A_QLOAD(dst, d) do { const bf16_t* Qw_ = Q + (size_t)((d).qrow0 + 32 * half + r32) * 1024 + ((d).kvh * 4 + g) * 64 + hi * 8; \
        _Pragma("unroll") for (int d0 = 0; d0 < 4; ++d0) dst[d0] = *(const bf16x8*)(Qw_ + d0 * 16); } while (0)
    int L = first; ADesc cur = a_desc(L); int gb = 0;
    bf16x8 qr[4], qn[4];
    float sk_cur = sink[cur.kvh * 4 + g], sk_nxt;
    A_QLOAD(qr, cur);
    { const size_t r0_ = (size_t)A_ROWOF(cur, 0) * KVP + cur.kvh * 64, r1_ = (size_t)A_ROWOF(cur, 1) * KVP + cur.kvh * 64;
      glds16(klane + r0_, RFL(dst0)); glds16(vlane + r0_, RFL(dst0 + 8192)); glds16(klane + r1_, RFL(dst0 + STG)); glds16(vlane + r1_, RFL(dst0 + STG + 8192)); }
    ATT_WAIT_BAR(2);
    asm volatile("" : "+v"(qr[0]), "+v"(qr[1]), "+v"(qr[2]), "+v"(qr[3]), "+v"(sk_cur));
    for (;;) {
        const int Ln = L + step; const bool has_next = Ln < U; const ADesc nxt = has_next ? a_desc(Ln) : cur;
        const int NT = cur.NT, NW = cur.NW, nlo = cur.nlo, head = cur.kvh * 4 + g;
        float mhat = sk_cur * 1.4426950408889634f, l = (hi == 0) ? 1.0f : 0.0f;
        f32x16 o[2], negm;
#pragma unroll
        for (int r = 0; r < 16; ++r) { o[0][r] = 0.f; o[1][r] = 0.f; negm[r] = -mhat; }
        u32x4 pw[4], pwn[4]; f32x16 sp0, sp1; s16x4 vlo[4], vhi[4];
#define A_MKDMA(n) const int t_ = (n) + 2; const bool own_ = t_ < NT; const bool on_ = own_ || has_next; \
        const size_t ro_ = own_ ? (size_t)A_ROWOF(cur, t_) * KVP + cur.kvh * 64 : (size_t)A_ROWOF(nxt, t_ - NT) * KVP + nxt.kvh * 64; \
        const DmaA dma_{klane + ro_, vlane + ro_, dst0 + ((gb + t_) & 3) * STG, on_}
#define A_ENDBAR(n) do { if ((n) + 2 < NT || has_next) ATT_WAIT_BAR(2); else ATT_WAIT_BAR(0); } while (0)
#define A_SK(n) (((n) < NW) ? (((nlo + (n)) == 0 && half == 1) ? 1 : (((nlo + (n)) == 4 && half == 0) ? 2 : 0)) : 0)
#define A_QKSTEP(n, D, RES, PV_, SK_, SKV) do { const ALAS char* sb_ = shm + ((gb + (n)) & 3) * STG; const ALAS char* vs_ = shm + ((gb + (n) - 1) & 3) * STG + 8192; const int np_ = nlo + (n); \
        if ((n) < NW && (np_ == 0 || np_ == 4)) { const int mr_ = 64 * np_ - 128 - 32 * half - r32; \
            if ((SK_) == SKV) RES = step_qk<true, PV_, SKV>(D, sb_, vs_, vlo, vhi, qr, sp0, sp1, negm, mhat, l, wsf, lane, r32, hi, false, mr_); \
            else RES = step_qk<true, PV_, 0>(D, sb_, vs_, vlo, vhi, qr, sp0, sp1, negm, mhat, l, wsf, lane, r32, hi, false, mr_); } \
        else RES = step_qk<false, PV_, 0>(D, sb_, vs_, vlo, vhi, qr, sp0, sp1, negm, mhat, l, wsf, lane, r32, hi, false, 0); } while (0)
        const int psk = A_SK(0);
        { bool rs_; { A_MKDMA(0); A_QKSTEP(0, dma_, rs_, false, psk, 1); }
          if (psk == 1) step_pv_sm<2, false, NoDma, 1, 0>(shm, vlo, vhi, o, pw, sp0, sp1, pwn, l, lane, hi); else step_pv_sm<2, false>(shm, vlo, vhi, o, pw, sp0, sp1, pwn, l, lane, hi);
          if (rs_) rescale_o<2>(o, wsf, hi);
#pragma unroll
          for (int i = 0; i < 4; ++i) pw[i] = pwn[i];
          A_ENDBAR(0); }
        for (int n = 1; n < NT; ++n) { bool rs_; const int sk = 0; { A_MKDMA(n); A_QKSTEP(n, dma_, rs_, true, sk, 2); }
            const ALAS char* vsp = shm + ((gb + n - 1) & 3) * STG + 8192;
            if (sk == 2) step_pv_sm<2, true, NoDma, 2, 0>(vsp, vlo, vhi, o, pw, sp0, sp1, pwn, l, lane, hi);
            else step_pv_sm<2, true>(vsp, vlo, vhi, o, pw, sp0, sp1, pwn, l, lane, hi);
            if (rs_) rescale_o<2>(o, wsf, hi);
#pragma unroll
            for (int i = 0; i < 4; ++i) pw[i] = pwn[i];
            A_ENDBAR(n); }
        { const DmaA nodma{klane, vlane, 0u, false}; step_y<2>(nodma, shm + ((gb + NT - 1) & 3) * STG + 8192, o, pw, lane, hi); }
#undef A_MKDMA
#undef A_ENDBAR
#undef A_QKSTEP
#undef A_SK
        sk_nxt = sink[nxt.kvh * 4 + g];
        A_QLOAD(qn, nxt);
        l = swapadd(l);
        if (hi == 0) wsf[32 + r32] = l;
        float rli[16];
#pragma unroll
        for (int r = 0; r < 16; ++r) rli[r] = __builtin_amdgcn_rcpf(wsf[32 + crow(r, hi)]);
        ALAS unsigned short* stg = (ALAS unsigned short*)(shm + OST_OFF) + wid * 2048;
#pragma unroll
        for (int r = 0; r < 16; ++r) { const int orow = crow(r, hi);
#pragma unroll
            for (int db = 0; db < 2; ++db) stg[orow * 64 + db * 32 + r32] = f2bf(o[db][r] * rli[r]); }
        bf16_t* Ow = O + (size_t)(cur.qrow0 + 32 * half) * 1024 + head * 64;
#pragma unroll
        for (int i = 0; i < 4; ++i) { const int row = i * 8 + (lane >> 3), ch = lane & 7; const u32x4 v = *(const ALAS u32x4*)(stg + row * 64 + ch * 8); *(u32x4*)(Ow + (size_t)row * 1024 + ch * 8) = v; }
        if (!has_next) break;
        asm volatile("" : "+v"(qn[0]), "+v"(qn[1]), "+v"(qn[2]), "+v"(qn[3]), "+v"(sk_nxt));
        gb = (gb + NT) & 3; cur = nxt; L = Ln; sk_cur = sk_nxt;
#pragma unroll
        for (int d0 = 0; d0 < 4; ++d0) qr[d0] = qn[d0];
    }
#undef A_ROWOF
#undef A_QLOAD
}

struct BDesc { int NW, NT, wrow0, crow0, qrow0, h; };
__device__ __forceinline__ BDesc b_desc(int L) {
    int pair, qb; if (L < 2048) { pair = L >> 4; qb = L & 15; } else { pair = (L - 2048) >> 1; qb = 16 + ((L - 2048) & 1); }
    const int b = pair >> 3; BDesc d; d.h = pair & 7; const bool lat = qb < 16;
    d.NW = lat ? 32 : 0; d.NT = d.NW + 4; d.wrow0 = b * 2048; d.crow0 = LROWS + b * 256;
    d.qrow0 = lat ? b * 2048 + qb * 128 : LROWS + b * 256 + (qb - 16) * 128;
    return d;
}
__device__ __forceinline__ void phase_B(ALAS char* shm, const bf16_t* Q, const bf16_t* K, const bf16_t* V, bf16_t* O, float lam, float osc, const float* subg, int first, int step, int U) {
    int tid_ = threadIdx.x; asm volatile("" : "+v"(tid_));
    const int tid = tid_, lane = tid & 63, r32 = lane & 31, hi = lane >> 5; const int wid = __builtin_amdgcn_readfirstlane(tid >> 6);
    constexpr int STG = 32768, KVP = 1024;
    if (first >= U) return;
    const int m = wid & 1, sub = wid >> 1;
    const bf16_t* klane = K + (size_t)(8 * wid + (lane >> 3)) * KVP + (((lane & 7) ^ ((wid & 1) * 4 + (lane >> 4))) << 3);
    const bf16_t* vlane = V + (size_t)(16 * (wid & 3) + (lane >> 2)) * KVP + (wid >> 2) * 32 + (lane & 3) * 8;
    const unsigned dst0 = (unsigned)(uintptr_t)shm + wid * 1024;
    ALAS float* wsf = (ALAS float*)(shm + WSF_OFF) + wid * 64;
#define B_ROWOF(d, n) ((n) < (d).NW ? (d).wrow0 + 64 * (n) : (d).crow0 + 64 * ((n) - (d).NW))
#define B_QLOAD(dst, d) do { int rq_ = r32, hq_ = hi; asm volatile("" : "+v"(rq_), "+v"(hq_));     \
        const bf16_t* Qw_ = Q + (size_t)((d).qrow0 + 32 * sub + rq_) * 1024 + (d).h * 128 + m * 64 + hq_ * 8; \
        _Pragma("unroll") for (int d0 = 0; d0 < 4; ++d0) dst[d0] = *(const bf16x8*)(Qw_ + d0 * 16); } while (0)
#define B_DMA_TILE(d, t) do { const size_t ro_ = (size_t)B_ROWOF(d, t) * KVP + (d).h * 128; const unsigned sb_ = dst0 + ((t) & 3) * STG; \
        glds16(klane + ro_, RFL(sb_)); glds16(klane + ro_ + 64, RFL(sb_ + 8192)); glds16(vlane + ro_, RFL(sb_ + 16384)); glds16(vlane + ro_ + 64, RFL(sb_ + 24576)); } while (0)
    int L = first; BDesc cur = b_desc(L);
    bf16x8 qr[4], qn[4];
    B_QLOAD(qr, cur);
    B_DMA_TILE(cur, 0); B_DMA_TILE(cur, 1);
    ATT_WAIT_BAR(4);
    asm volatile("" : "+v"(qr[0]), "+v"(qr[1]), "+v"(qr[2]), "+v"(qr[3]));
    for (;;) {
        const int Ln = L + step; const bool has_next = Ln < U; const BDesc nxt = has_next ? b_desc(Ln) : cur;
        const int NT = cur.NT;
        float mhat = 0.f, l = 0.f;
        f32x16 o[4], negm;
#pragma unroll
        for (int r = 0; r < 16; ++r) negm[r] = 0.f;
#pragma unroll
        for (int db = 0; db < 4; ++db)
#pragma unroll
            for (int r = 0; r < 16; ++r) o[db][r] = 0.f;
        u32x4 pw[4];
#define MKDMA(t) const int t_ = (t); const bool own_ = t_ < NT; const size_t ro_ = own_ ? (size_t)B_ROWOF(cur, t_) * KVP + cur.h * 128 : (size_t)B_ROWOF(nxt, t_ - NT) * KVP + nxt.h * 128; \
        const DmaB dma_{klane + ro_, vlane + ro_, dst0 + (t_ & 3) * STG, true}
#define YSTEP(n, D) step_y<4>(D, shm + ((n) & 3) * STG + 16384, o, pw, lane, hi)
#define ENDBAR(n) do { if ((n) + 1 < NT || has_next) ATT_WAIT_BAR(4); else ATT_WAIT_BAR(0); } while (0)
        const DmaB nodma{klane, vlane, 0u, false};
        f32x16 sp0, sp1; u32x4 pwn[4]; s16x4 vlo[4], vhi[4];
        { bool rs_; { MKDMA(2); rs_ = step_qk<false, false>(dma_, shm + m * 8192, shm, vlo, vhi, qr, sp0, sp1, negm, mhat, l, wsf, lane, r32, hi, true, 0); } step_pv_sm<4, false>(shm, vlo, vhi, o, pw, sp0, sp1, pwn, l, lane, hi); (void)rs_;
#pragma unroll
          for (int i = 0; i < 4; ++i) pw[i] = pwn[i];
          ENDBAR(0); }
#define BSTEP(n, PWO, PWN) do { bool rs_; { MKDMA((n) + 2); rs_ = step_qk<false, true>(nodma, shm + ((n) & 3) * STG + m * 8192, shm + (((n) - 1) & 3) * STG + 16384, vlo, vhi, qr, sp0, sp1, negm, mhat, l, wsf, lane, r32, hi, false, 0); \
            step_pv_sm<4, true, DmaB>(shm + (((n) - 1) & 3) * STG + 16384, vlo, vhi, o, PWO, sp0, sp1, PWN, l, lane, hi, dma_); } if (rs_) rescale_o<4>(o, wsf, hi); \
            ENDBAR(n); } while (0)
        for (int n = 1; n + 1 < NT; n += 2) { BSTEP(n, pw, pwn); BSTEP(n + 1, pwn, pw); }
        BSTEP(NT - 1, pw, pwn);
#pragma unroll
        for (int i = 0; i < 4; ++i) pw[i] = pwn[i];
#undef BSTEP
        int r32e = r32, hie = hi, lanee = lane; asm volatile("" : "+v"(r32e), "+v"(hie), "+v"(lanee));
        float gsub[4];
#pragma unroll
        for (int db = 0; db < 4; ++db) gsub[db] = subg[db * 32 + r32e];
        B_QLOAD(qn, nxt);
        YSTEP(NT - 1, nodma);
#undef MKDMA
#undef YSTEP
#undef ENDBAR
        ATT_BAR();
        l = swapadd(l);
        if (hie == 0) wsf[32 + r32e] = l;
        float rli[16];
#pragma unroll
        for (int r = 0; r < 16; ++r) rli[r] = __builtin_amdgcn_rcpf(wsf[32 + crow(r, hie)]);
        ALAS float* cb = (ALAS float*)(shm + 65536 + sub * 16384);
#define B_GIVE(G0, SC) do { _Pragma("unroll") for (int r = G0; r < G0 + 8; ++r) { const int orow = crow(r, hie); const float sc = rli[r] * (SC); \
            _Pragma("unroll") for (int db = 0; db < 4; ++db) cb[orow * 128 + db * 32 + r32e] = o[db][r] * sc; } } while (0)
        if (m == 0) B_GIVE(8, 1.0f); else B_GIVE(0, lam);
#undef B_GIVE
        __syncthreads();
        float ss[8];
#define B_COMB(K0, OWN) do { _Pragma("unroll") for (int r = K0; r < K0 + 8; ++r) { const int orow = crow(r, hie); float q = 0.f; const float sc = rli[r] * (OWN); \
            _Pragma("unroll") for (int db = 0; db < 4; ++db) { const float c = cb[orow * 128 + db * 32 + r32e]; const float x = (K0 == 0) ? o[db][r] * sc - c : c - o[db][r] * sc; o[db][r] = x; q += x * x; } \
            ss[r - K0] = q; } } while (0)
        if (m == 0) B_COMB(0, 1.0f); else B_COMB(8, lam);
#undef B_COMB
#pragma unroll
        for (int r = 0; r < 8; ++r) { const float q = half_sum32v(ss[r]); ss[r] = osc * __builtin_amdgcn_rsqf(q * (1.0f / 128.0f) + 1e-5f); }
        asm volatile("s_waitcnt lgkmcnt(0)" ::: "memory");
        ALAS unsigned short* stg = (ALAS unsigned short*)(shm + 65536 + sub * 16384 + m * 8192);
#define B_STG(K0) do { _Pragma("unroll") for (int r = K0; r < K0 + 8; ++r) { const int orow = crow(r, hie) - 2 * K0; \
            _Pragma("unroll") for (int db = 0; db < 4; ++db) stg[orow * 128 + db * 32 + r32e] = f2bf(o[db][r] * ss[r - K0] * gsub[db]); } } while (0)
        if (m == 0) B_STG(0); else B_STG(8);
#undef B_STG
        bf16_t* Ow = O + (size_t)(cur.qrow0 + 32 * sub + 16 * m) * 1024 + cur.h * 128;
#pragma unroll
        for (int i = 0; i < 4; ++i) { const int row = i * 4 + (lanee >> 4), ch = lanee & 15; const u32x4 v = *(const ALAS u32x4*)(stg + row * 128 + ch * 8); *(u32x4*)(Ow + (size_t)row * 1024 + ch * 8) = v; }
        if (!has_next) { __syncthreads(); break; }
        asm volatile("" : "+v"(qn[0]), "+v"(qn[1]), "+v"(qn[2]), "+v"(qn[3]));
        ATT_WAIT_BAR(4);
        cur = nxt; L = Ln;
#pragma unroll
        for (int d0 = 0; d0 < 4; ++d0) qr[d0] = qn[d0];
    }
#undef B_ROWOF
#undef B_QLOAD
#undef B_DMA_TILE
}
#undef RFL
#undef ATT_WAIT_BAR
#undef ATT_BAR
#undef ALAS
}

#ifndef MK_PER_PHASE
#define MK_PER_PHASE 0
#endif
constexpr int NWAVES = 8;
constexpr int DM = 1024, NBATCH = 16, SEQ = 2048, CTXL = 256, LROWS = NBATCH * SEQ, CROWS = NBATCH * CTXL, MROWS = LROWS + CROWS, NEXP = 16, DEPTH = 4;
constexpr float DN_ALPHA = 1.6817928305074292f;
constexpr float LN_EPS = 1e-6f;
constexpr float QSCALE = 0.125f * 1.4426950408889634f;
constexpr int NPHASE = 2 + 8 * DEPTH;

constexpr size_t MiB = 1u << 20;
constexpr size_t WS_CTL = 0, CTL_ZERO_BYTES = 1 * MiB;
constexpr size_t WS_MOD = 1 * MiB;
constexpr size_t WS_ROPE = 3 * MiB;
constexpr size_t WS_TOKE = 4 * MiB;
constexpr size_t WS_TOKW = 4 * MiB + 512 * 1024;
constexpr size_t WS_TOKP = 5 * MiB;
constexpr size_t WS_BCNT = 5 * MiB + 512 * 1024;
constexpr size_t WS_META = 5 * MiB + 768 * 1024;
constexpr size_t WS_ROWL = 6 * MiB;
constexpr size_t WS_XC = 662 * MiB;
constexpr size_t WS_WQKVA = 16 * MiB, WS_WOA = 22 * MiB, WS_WQKVB = 26 * MiB, WS_WOB = 38 * MiB;
constexpr size_t WS_WGU = 42 * MiB;
constexpr size_t WS_WDN = 170 * MiB;
constexpr size_t WS_HL = 234 * MiB;
constexpr size_t WS_Q = 306 * MiB, WS_K = 378 * MiB, WS_V = 450 * MiB;
constexpr size_t WS_XG = 306 * MiB;
constexpr size_t WS_AL = 522 * MiB;
constexpr size_t WS_XB = 598 * MiB;
constexpr size_t WS_END = 670 * MiB;
constexpr int CW_BAR = 4096;

constexpr int RING_BYTES = 135168, MISC_OFF = RING_BYTES, ROWTAB_OFF = 137216  , LDS_BYTES = 147456;

#define GAS __attribute__((address_space(1)))
#define LAS __attribute__((address_space(3)))
typedef unsigned short bf16;
typedef float f32x4 __attribute__((ext_vector_type(4)));
typedef unsigned u32x4 __attribute__((ext_vector_type(4)));
typedef unsigned u32x2 __attribute__((ext_vector_type(2)));
typedef GAS unsigned gu32;
#define RLX_AGENT __ATOMIC_RELAXED, __HIP_MEMORY_SCOPE_AGENT
#define LDS_WAIT() asm volatile("s_waitcnt lgkmcnt(0)" ::: "memory")
__device__ __forceinline__ unsigned f2bf(float f) { unsigned u = __builtin_bit_cast(unsigned, f); return (u + 0x7fffu + ((u >> 16) & 1u)) >> 16; }
typedef float pk_f32x2 __attribute__((ext_vector_type(2))); typedef __bf16 pk_bf16x2 __attribute__((ext_vector_type(2)));
__device__ __forceinline__ unsigned pk2(float lo, float hi) { pk_f32x2 v = {lo, hi}; pk_bf16x2 b = __builtin_convertvector(v, pk_bf16x2); return __builtin_bit_cast(unsigned, b); }
__device__ __forceinline__ float bflo(unsigned w) { return __uint_as_float(w << 16); }
__device__ __forceinline__ float bfhi(unsigned w) { return __uint_as_float(w & 0xffff0000u); }

#define XB_TMO      128
#define XB_XCNT(j)  (256  + 64 * (j))
#define XB_XSUB(j)  (1280 + 64 * (j))
#define XB_XGEN(j)  (2304 + 64 * (j))
#define XB_TOP      3328
#define XB_TOPGEN   3392
#define XCD_BAR_WORDS 3456
#define XB_SPIN_CAP (1u << 18)
__device__ __forceinline__ unsigned xb_ld(unsigned* p)              { return __hip_atomic_load(p, __ATOMIC_RELAXED, __HIP_MEMORY_SCOPE_AGENT); }
__device__ __forceinline__ unsigned xb_add(unsigned* p, unsigned v) { return __hip_atomic_fetch_add(p, v, __ATOMIC_RELAXED, __HIP_MEMORY_SCOPE_AGENT); }
__device__ __forceinline__ unsigned xb_xcc_id() { return (unsigned)__builtin_amdgcn_s_getreg((3 << 11) | 20) & 0xFu; }
#define XB_SPIN(cond, bar) do { unsigned _sp = 0; while (cond) { __builtin_amdgcn_s_sleep(1); \
    if ((++_sp & 255u) == 0u) { if (xb_ld(&(bar)[XB_TMO])) break; if (_sp > XB_SPIN_CAP) { atomicAdd(&(bar)[XB_TMO], 1u); break; } } } } while (0)
struct XcdBarrier { unsigned* bar; unsigned x; volatile LAS unsigned* st; };
__device__ __forceinline__ XcdBarrier xcd_barrier_post(unsigned* bar, volatile LAS unsigned* st) {
    XcdBarrier b; b.bar = bar; b.x = xb_xcc_id(); b.st = st;
    if (threadIdx.x == 0) (void)xb_add(&bar[XB_XCNT(b.x)], 1u);
    return b;
}
__device__ __forceinline__ void xcd_barrier_complete(unsigned* bar, unsigned x, unsigned& nloc, unsigned& nx) {
    const unsigned G = gridDim.x * gridDim.y * gridDim.z;
    unsigned sum, cnt, mine, sp = 0u;
    for (;;) {
        sum = 0u; cnt = 0u; mine = 0u;
#pragma unroll
        for (unsigned j = 0; j < 16; ++j) { const unsigned c = xb_ld(&bar[XB_XCNT(j)]); sum += c; cnt += (c > 0u) ? 1u : 0u; mine = (j == x) ? c : mine; }
        if (sum == G) break;
        __builtin_amdgcn_s_sleep(1);
        if ((++sp & 255u) == 0u) { if (xb_ld(&bar[XB_TMO])) break; if (sp > XB_SPIN_CAP) { atomicAdd(&bar[XB_TMO], 1u); break; } }
    }
    nloc = mine > 0u ? mine : 1u; nx = cnt > 0u ? cnt : 1u;
}
__device__ __forceinline__ void xcd_barrier(const XcdBarrier& b) {
    asm volatile("s_waitcnt vmcnt(0)" ::: "memory");
    __syncthreads();
    if (threadIdx.x == 0) {
        unsigned* bar = b.bar;
        __builtin_amdgcn_s_waitcnt(0);
        unsigned nloc = b.st[0], nx = b.st[1];
        if (nloc == 0u) { xcd_barrier_complete(bar, b.x, nloc, nx); b.st[0] = nloc; b.st[1] = nx; }
        const unsigned old = xb_add(&bar[XB_XSUB(b.x)], 1u);
        const unsigned gen = old / nloc;
        if (old + 1u == (gen + 1u) * nloc) {
            __builtin_amdgcn_fence(__ATOMIC_RELEASE, "agent");
            asm volatile("s_waitcnt vmcnt(0)" ::: "memory");
            const unsigned og = xb_add(&bar[XB_TOP], 1u);
            const unsigned tg = og / nx;
            if (og + 1u == (tg + 1u) * nx) xb_add(&bar[XB_TOPGEN], 1u);
            else XB_SPIN(xb_ld(&bar[XB_TOPGEN]) == tg, bar);
            __builtin_amdgcn_fence(__ATOMIC_ACQUIRE, "agent");
            xb_add(&bar[XB_XGEN(b.x)], 1u);
            asm volatile("s_waitcnt vmcnt(0)" ::: "memory");
        } else {
            XB_SPIN(xb_ld(&bar[XB_XGEN(b.x)]) == gen, bar);
            __builtin_amdgcn_fence(__ATOMIC_ACQUIRE, "agent");
            asm volatile("s_waitcnt vmcnt(0)" ::: "memory");
        }
    }
    __syncthreads();
}

struct Args { const float* in[22]; float* out; unsigned char* ws; int ph_lo, ph_hi; };

typedef const float* CFP_; typedef __attribute__((address_space(4))) const CFP_* KIn;
struct Frame {
    LAS unsigned char* lds; volatile LAS unsigned* MISC;
    int tid, lane, wave, vcu, G, gw, NGW, rpw;
    KIn in; float* out; unsigned char* ws;
};
__device__ __forceinline__ void fresh_in(Frame& F) { KIn p = (KIn)__builtin_amdgcn_kernarg_segment_ptr(); asm volatile("" : "+s"(p)); F.in = p; }

template <int X> __device__ __forceinline__ float lane_xor(float v) {
    if (X == 1) return __builtin_bit_cast(float, __builtin_amdgcn_update_dpp(0, __builtin_bit_cast(int, v), 0xB1, 0xF, 0xF, true));
    if (X == 2) return __builtin_bit_cast(float, __builtin_amdgcn_update_dpp(0, __builtin_bit_cast(int, v), 0x4E, 0xF, 0xF, true));
    return __builtin_bit_cast(float, __builtin_amdgcn_ds_swizzle(__builtin_bit_cast(int, v), (X << 10) | 0x1F));
}
template <int N> __device__ __forceinline__ float dpp_ror(float v) { return __builtin_bit_cast(float, __builtin_amdgcn_update_dpp(0, __builtin_bit_cast(int, v), 0x120 | N, 0xF, 0xF, true)); }
__device__ __forceinline__ float row_sum16(float v) { v += dpp_ror<8>(v); v += dpp_ror<4>(v); v += dpp_ror<2>(v); v += dpp_ror<1>(v); return v; }
__device__ __forceinline__ float half_sum(float v) { v = row_sum16(v);
    auto rr = __builtin_amdgcn_permlane16_swap(__float_as_uint(v), __float_as_uint(v), false, false); return __uint_as_float(rr[0]) + __uint_as_float(rr[1]); }
__device__ __forceinline__ float wave_sum(float v) {
    v = half_sum(v);
    auto rr = __builtin_amdgcn_permlane32_swap(__float_as_uint(v), __float_as_uint(v), false, false);
    return __uint_as_float(rr[0]) + __uint_as_float(rr[1]);
}
template <int MAP> __device__ __forceinline__ int map_row(int n) {
    if (MAP == 1) return (n & ~31) + 2 * (n & 15) + ((n >> 4) & 1);
    if (MAP == 2) return 8 * (n >> 2) + (n & 3);
    if (MAP == 3) return 8 * (n >> 2) + 4 + (n & 3);
    return n;
}
template <int MAP> __device__ __forceinline__ void transpose_item(const float* W, int K, int N, bf16* WT, LAS unsigned* scr, int item, int lane) {
    const int nblk = N / 64, kb = item / nblk, nb = item % nblk, k0 = 64 * kb, n0 = 64 * nb;
    const GAS float* src = (const GAS float*)W + (size_t)k0 * N + n0 + lane;
    float v[64];
#pragma unroll
    for (int t = 0; t < 64; ++t) v[t] = src[(size_t)t * N];
#pragma unroll
    for (int t = 0; t < 32; ++t) scr[lane * 33 + t] = pk2(v[2 * t], v[2 * t + 1]);
    LDS_WAIT(); asm volatile("" ::: "memory");
#pragma unroll
    for (int j = 0; j < 8; ++j) { const int row = j * 8 + (lane >> 3), ch = lane & 7; const LAS unsigned* sp = scr + row * 33 + ch * 4;
        u32x4 o; o.x = sp[0]; o.y = sp[1]; o.z = sp[2]; o.w = sp[3];
        *(GAS u32x4*)(WT + (size_t)map_row<MAP>(n0 + row) * K + k0 + ch * 8) = o; }
    LDS_WAIT(); asm volatile("" ::: "memory");
}
__device__ __forceinline__ void sincos_small(float x, float& s, float& c) {
    const float kf = rintf(x * 0.636619772367581f); const int k = (int)kf;
    float r = fmaf(-kf, 1.5703125f, x); r = fmaf(-kf, 4.837512969970703125e-4f, r); r = fmaf(-kf, 7.54978995489188216e-8f, r);
    const float r2 = r * r;
    const float sp = r + r * r2 * (-1.6666654611e-1f + r2 * (8.3321608736e-3f + r2 * (-1.9515295891e-4f)));
    const float cp = 1.0f - 0.5f * r2 + r2 * r2 * (4.166664568298827e-2f + r2 * (-1.388731625493765e-3f + r2 * 2.443315711809948e-5f));
    const int q = k & 3;
    s = (q == 0) ? sp : (q == 1) ? cp : (q == 2) ? -sp : -cp;
    c = (q == 0) ? cp : (q == 1) ? -sp : (q == 2) ? -cp : sp;
}

__device__ __forceinline__ void convert_experts(Frame& F, int layer, int w, int nw) {
    fresh_in(F);
    int t_ = threadIdx.x; asm volatile("" : "+v"(t_)); const int lane = t_ & 63;
    LAS unsigned* scr = (LAS unsigned*)(F.lds + F.wave * 16384);
    bf16* wgu = (bf16*)(F.ws + WS_WGU); bf16* wdn = (bf16*)(F.ws + WS_WDN);
    constexpr int I_G = 16 * 8, I_D = 8 * 16, N_G = 16 * I_G, N_D = 16 * I_D;
    for (int it = w; it < 2 * N_G + N_D; it += nw) {
        int r = it;
        if (r < N_G) { const int mi = layer * 16 + r / I_G, ii = r % I_G; transpose_item<2>(F.in[19] + (size_t)mi * 1024 * 512, 1024, 512, wgu + (size_t)mi * 1024 * 1024, scr, ii, lane); continue; } r -= N_G;
        if (r < N_G) { const int mi = layer * 16 + r / I_G, ii = r % I_G; transpose_item<3>(F.in[20] + (size_t)mi * 1024 * 512, 1024, 512, wgu + (size_t)mi * 1024 * 1024, scr, ii, lane); continue; } r -= N_G;
        { const int mi = layer * 16 + r / I_D, ii = r % I_D; transpose_item<0>(F.in[21] + (size_t)mi * 512 * 1024, 512, 1024, wdn + (size_t)mi * 1024 * 512, scr, ii, lane); }
    }
}
__device__ __forceinline__ void ph_prologue(Frame F) {
    { int t_ = threadIdx.x; asm volatile("" : "+v"(t_)); F.tid = t_; F.lane = t_ & 63; fresh_in(F); }
    const float* c = F.in[1]; const float* cctx = F.in[3]; const float* w_ada = F.in[4]; const float* b_ada = F.in[5];
    float* mod = (float*)(F.ws + WS_MOD);
    for (int task = F.vcu; task < 192; task += F.G) {
        const int li = task / 48, jc = task % 48;
        LAS float* s = (LAS float*)F.lds;
        LAS float* part = (LAS float*)(F.lds + 17 * 1024 * 4);
        for (int idx = F.tid; idx < 17 * 1024; idx += NWAVES * 64) { const int r = idx >> 10, k = idx & 1023; const float v = r < 16 ? c[r * 1024 + k] : cctx[k]; s[idx] = v / (1.0f + expf(-v)); }
        __syncthreads();
        const int ch = F.wave & 1, kq = F.wave >> 1, j = jc * 128 + ch * 64 + F.lane;
        const float* wu = w_ada + ((size_t)li * 1024 + kq * 256) * 6144 + jc * 128 + ch * 64;
        float acc[17];
#pragma unroll
        for (int r = 0; r < 17; ++r) acc[r] = 0.f;
        for (int kb = 0; kb < 8; ++kb) {
            float wv[32];
#pragma unroll
            for (int t = 0; t < 32; ++t) wv[t] = wu[(size_t)(32 * kb + t) * 6144 + F.lane];
            __builtin_amdgcn_sched_barrier(0);
#pragma unroll
            for (int k4 = 0; k4 < 8; ++k4)
#pragma unroll
                for (int r = 0; r < 17; ++r) { const f32x4 sv = *(const LAS f32x4*)(s + r * 1024 + kq * 256 + 32 * kb + 4 * k4);
                    acc[r] = fmaf(sv[0], wv[4 * k4], acc[r]); acc[r] = fmaf(sv[1], wv[4 * k4 + 1], acc[r]); acc[r] = fmaf(sv[2], wv[4 * k4 + 2], acc[r]); acc[r] = fmaf(sv[3], wv[4 * k4 + 3], acc[r]); }
            __builtin_amdgcn_sched_barrier(0);
        }
#pragma unroll
        for (int r = 0; r < 17; ++r) part[(kq * 17 + r) * 128 + ch * 64 + F.lane] = acc[r];
        __syncthreads();
        for (int idx = F.tid; idx < 17 * 128; idx += NWAVES * 64) { const int r = idx >> 7, jj = idx & 127;
            const float v = (part[(0 * 17 + r) * 128 + jj] + part[(1 * 17 + r) * 128 + jj]) + (part[(2 * 17 + r) * 128 + jj] + part[(3 * 17 + r) * 128 + jj]);
            mod[((size_t)li * 17 + r) * 6144 + jc * 128 + jj] = v + b_ada[li * 6144 + jc * 128 + jj]; }
        __syncthreads();
    }
    {
        float* rope = (float*)(F.ws + WS_ROPE);
        for (int idx = F.gw * 64 + F.lane; idx < 2048 * 32; idx += F.NGW * 64) { const int pos = idx >> 5, pi = idx & 31, j = pi & 15;
            const float ax = (float)(pi < 16 ? (pos >> 6) : (pos & 63)); const float inv = exp2f(-(float)j * (13.287712379549449f / 16.0f));
            float sn, cs; sincos_small(ax * inv, sn, cs); rope[idx * 2] = cs; rope[idx * 2 + 1] = sn; }
    }
    LAS unsigned* scr = (LAS unsigned*)(F.lds + F.wave * 16384);
    bf16* wqa = (bf16*)(F.ws + WS_WQKVA); bf16* woa = (bf16*)(F.ws + WS_WOA); bf16* wqb = (bf16*)(F.ws + WS_WQKVB); bf16* wob = (bf16*)(F.ws + WS_WOB);
    constexpr int I_QA = 16 * 24, I_O = 16 * 16, I_QB = 16 * 48;
    constexpr int N_QA = 2 * I_QA, N_OA = 2 * I_O, N_QB = 2 * I_QB, N_OB = 2 * I_O;
    constexpr int NITEMS = N_QA + N_OA + N_QB + N_OB;
    for (int it = F.gw; it < NITEMS; it += F.NGW) {
        int r = it;
        if (r < N_QA) { const int mi = r / I_QA, ii = r % I_QA; const int nb = ii % 24;
            if (nb < 20) transpose_item<1>(F.in[6] + (size_t)mi * 1024 * 1536, 1024, 1536, wqa + (size_t)mi * 1536 * 1024, scr, ii, F.lane);
            else transpose_item<0>(F.in[6] + (size_t)mi * 1024 * 1536, 1024, 1536, wqa + (size_t)mi * 1536 * 1024, scr, ii, F.lane);
            continue; } r -= N_QA;
        if (r < N_OA) { const int mi = r / I_O, ii = r % I_O; transpose_item<0>(F.in[7] + (size_t)mi * 1024 * 1024, 1024, 1024, woa + (size_t)mi * 1024 * 1024, scr, ii, F.lane); continue; } r -= N_OA;
        if (r < N_QB) { const int mi = r / I_QB, ii = r % I_QB; const int nb = ii % 48;
            if (nb < 32) transpose_item<1>(F.in[9] + (size_t)mi * 1024 * 3072, 1024, 3072, wqb + (size_t)mi * 3072 * 1024, scr, ii, F.lane);
            else transpose_item<0>(F.in[9] + (size_t)mi * 1024 * 3072, 1024, 3072, wqb + (size_t)mi * 3072 * 1024, scr, ii, F.lane);
            continue; } r -= N_QB;
        { const int mi = r / I_O, ii = r % I_O; transpose_item<0>(F.in[10] + (size_t)mi * 1024 * 1024, 1024, 1024, wob + (size_t)mi * 1024 * 1024, scr, ii, F.lane); }
    }
}

__device__ __forceinline__ void ld_f32(const float* p, int lane, f32x4 (&v)[4]) {
#pragma unroll
    for (int j = 0; j < 4; ++j) v[j] = ((const GAS f32x4*)p)[64 * j + lane];
}
__device__ __forceinline__ void ld_bf16(const bf16* p, int lane, f32x4 (&v)[4]) {
#pragma unroll
    for (int j = 0; j < 4; ++j) { const u32x2 w = ((const GAS u32x2*)p)[64 * j + lane]; v[j] = (f32x4){bflo(w.x), bfhi(w.x), bflo(w.y), bfhi(w.y)}; }
}
__device__ __forceinline__ void st_f32(float* p, int lane, const f32x4 (&v)[4]) {
#pragma unroll
    for (int j = 0; j < 4; ++j) ((GAS f32x4*)p)[64 * j + lane] = v[j];
}
__device__ __forceinline__ void st_bf16(bf16* p, int lane, const f32x4 (&v)[4]) {
#pragma unroll
    for (int j = 0; j < 4; ++j) { u32x2 w; w.x = pk2(v[j][0], v[j][1]); w.y = pk2(v[j][2], v[j][3]); ((GAS u32x2*)p)[64 * j + lane] = w; }
}
__device__ __forceinline__ void ln_core(f32x4 (&v)[4]) {
    float s = 0.f;
#pragma unroll
    for (int j = 0; j < 4; ++j) s += (v[j][0] + v[j][1]) + (v[j][2] + v[j][3]);
    const float mean = wave_sum(s) * (1.0f / DM); float q = 0.f;
#pragma unroll
    for (int j = 0; j < 4; ++j) { v[j] = v[j] - mean; q += (v[j][0] * v[j][0] + v[j][1] * v[j][1]) + (v[j][2] * v[j][2] + v[j][3] * v[j][3]); }
    const float rstd = __builtin_amdgcn_rsqf(wave_sum(q) * (1.0f / DM) + LN_EPS);
#pragma unroll
    for (int j = 0; j < 4; ++j) v[j] = v[j] * rstd;
}

__device__ __forceinline__ void ph_hl0(Frame F) {
    { int t_ = threadIdx.x; asm volatile("" : "+v"(t_)); F.tid = t_; F.lane = t_ & 63; fresh_in(F); }
    const float* mod = (const float*)(F.ws + WS_MOD); bf16* HL = (bf16*)(F.ws + WS_HL);
    const int r0 = F.gw * F.rpw, r1 = min(r0 + F.rpw, MROWS);
    int bcur = -1; f32x4 sc[4], sh[4], v[4], nx[4];
    if (r0 < r1) ld_f32(r0 < LROWS ? F.in[0] + (size_t)r0 * DM : F.in[2] + (size_t)(r0 - LROWS) * DM, F.lane, v);
    for (int row = r0; row < r1; ++row) {
        const int b = row < LROWS ? row >> 11 : 16;
        if (b != bcur) { bcur = b; const float* mb = mod + ((size_t)0 * 17 + b) * 6144; ld_f32(mb, F.lane, sh); ld_f32(mb + 1024, F.lane, sc); }
        if (row + 1 < r1) { const int rn = row + 1; ld_f32(rn < LROWS ? F.in[0] + (size_t)rn * DM : F.in[2] + (size_t)(rn - LROWS) * DM, F.lane, nx); }
        st_bf16((bf16*)(F.ws + WS_XB) + (size_t)row * DM, F.lane, v);
#pragma unroll
        for (int j = 0; j < 4; ++j) v[j] = v[j] * (sc[j] + 1.0f) + sh[j];
        st_bf16(HL + (size_t)row * DM, F.lane, v);
#pragma unroll
        for (int j = 0; j < 4; ++j) v[j] = nx[j];
    }
}

__device__ __forceinline__ void ph_ln1(Frame F, int li, int Mr) {
    { int t_ = threadIdx.x; asm volatile("" : "+v"(t_)); F.tid = t_; F.lane = t_ & 63; fresh_in(F); }
    const float* mod = (const float*)(F.ws + WS_MOD);
    const bf16* AL = (const bf16*)(F.ws + WS_AL); bf16* H2 = (bf16*)(F.ws + WS_HL);
    int* toke = (int*)(F.ws + WS_TOKE); float* tokw = (float*)(F.ws + WS_TOKW); int* bcnt = (int*)(F.ws + WS_BCNT);
    bf16* xb = (bf16*)(F.ws + WS_XB); static_assert(WS_XC == WS_XB + (size_t)LROWS * DM * 2, "context rows follow the latent rows");
    LAS float* wr = (LAS float*)F.lds;
    { const float* wrg = F.in[17];
      for (int idx = F.tid; idx < 1024 * 16; idx += NWAVES * 64) { const int k = idx >> 4, e = idx & 15; const int j = k >> 8, ln = (k & 255) >> 2, cc = k & 3, q = e >> 2, t = e & 3;
          wr[((((j * 4 + cc) * 4 + q) * 64 + ln) << 2) + t] = wrg[idx]; } }
    if (F.tid < 16) F.MISC[16 + F.tid] = 0u;
    __syncthreads();
    const int qg = F.lane >> 4;
    const int ex = 8 * ((F.lane >> 4) & 1) + ((F.lane & 15) >> 1);
    const bool hi8 = (F.lane & 8) != 0, b2 = (F.lane & 4) != 0, b1 = (F.lane & 2) != 0, oddrow = (F.lane & 16) != 0;
    const float rbv = F.in[18][ex];
    f32x4 lg[4], lb[4]; ld_f32(F.in[13] + li * DM, F.lane, lg); ld_f32(F.in[14] + li * DM, F.lane, lb);
    const int wb = F.vcu * NWAVES * F.rpw, we = min(wb + NWAVES * F.rpw, Mr), ppw = (((we - wb) >> 1) + NWAVES - 1) / NWAVES;
    const int r0 = wb + 2 * F.wave * ppw, r1 = min(r0 + 2 * ppw, we);
    int bcur = -1; f32x4 g1[4], sc2[4], sh2[4]; u32x2 nv[4], na[4];
#define LN1_LDX(R) do { const int rn_ = (R); const bf16* xs_ = xb + (size_t)rn_ * DM; \
        _Pragma("unroll") for (int j = 0; j < 4; ++j) { nv[j] = ((const GAS u32x2*)xs_)[64 * j + F.lane]; na[j] = ((const GAS u32x2*)(AL + (size_t)rn_ * DM))[64 * j + F.lane]; } } while (0)
    if (r0 < r1) LN1_LDX(r0);
    typedef float f32x2p __attribute__((ext_vector_type(2)));
    for (int row0 = r0; row0 < r1; row0 += 2) {
        f32x4 h[2][4];
        { const int b = row0 < LROWS ? row0 >> 11 : 16;
            if (b != bcur) { bcur = b; const float* mb = mod + ((size_t)li * 17 + b) * 6144; ld_f32(mb + 2048, F.lane, g1); ld_f32(mb + 3072, F.lane, sh2); ld_f32(mb + 4096, F.lane, sc2);
#pragma unroll
                for (int j = 0; j < 4; ++j) sc2[j] = sc2[j] + 1.0f; } }
#pragma unroll
        for (int s = 0; s < 2; ++s) {
            const int row = row0 + s;
            bf16* xo = xb + (size_t)row * DM;
            f32x4 v[4];
#pragma unroll
            for (int j = 0; j < 4; ++j) v[j] = (f32x4){bflo(nv[j].x), bfhi(nv[j].x), bflo(nv[j].y), bfhi(nv[j].y)} * DN_ALPHA + g1[j] * (f32x4){bflo(na[j].x), bfhi(na[j].x), bflo(na[j].y), bfhi(na[j].y)};
            if (row0 + s + 1 < r1) LN1_LDX(row0 + s + 1);
            ln_core(v);
#pragma unroll
            for (int j = 0; j < 4; ++j) v[j] = v[j] * lg[j] + lb[j];
            st_bf16(xo, F.lane, v);
#pragma unroll
            for (int j = 0; j < 4; ++j) v[j] = v[j] * sc2[j] + sh2[j];
            st_bf16(H2 + (size_t)row * DM, F.lane, v);
#pragma unroll
            for (int j = 0; j < 4; ++j) h[s][j] = v[j];
        }
        f32x2p lgA[8], lgB[8];
#pragma unroll
        for (int e = 0; e < 8; ++e) { lgA[e] = (f32x2p){0.f, 0.f}; lgB[e] = (f32x2p){0.f, 0.f}; }
#pragma unroll
        for (int j = 0; j < 4; ++j) {
#pragma unroll
            for (int hf = 0; hf < 2; ++hf) {
                f32x4 w4[8];
#pragma unroll
                for (int i = 0; i < 8; ++i) w4[i] = *(const LAS f32x4*)(wr + (((j * 16 + hf * 8 + i) * 64 + F.lane) << 2));
                __builtin_amdgcn_sched_barrier(0);
#pragma unroll
                for (int c2 = 0; c2 < 2; ++c2) { const int cc = hf * 2 + c2; const f32x2p ha = (f32x2p){h[0][j][cc], h[0][j][cc]}, hb = (f32x2p){h[1][j][cc], h[1][j][cc]};
#pragma unroll
                    for (int q = 0; q < 4; ++q) { const f32x4 w = w4[c2 * 4 + q]; const f32x2p wl = (f32x2p){w[0], w[1]}, wh = (f32x2p){w[2], w[3]};
                        lgA[2 * q] = __builtin_elementwise_fma(ha, wl, lgA[2 * q]); lgA[2 * q + 1] = __builtin_elementwise_fma(ha, wh, lgA[2 * q + 1]);
                        lgB[2 * q] = __builtin_elementwise_fma(hb, wl, lgB[2 * q]); lgB[2 * q + 1] = __builtin_elementwise_fma(hb, wh, lgB[2 * q + 1]); } }
#pragma unroll
                for (int e = 0; e < 8; ++e) asm volatile("" : "+v"(lgA[e]), "+v"(lgB[e]));
                __builtin_amdgcn_sched_barrier(0);
            }
        }
        {
#define LN1_DPPF(CTRL, X) __builtin_bit_cast(float, __builtin_amdgcn_update_dpp(0, __builtin_bit_cast(int, (X)), (CTRL), 0xF, 0xF, true))
#define LN1_DPPI(CTRL, X) __builtin_amdgcn_update_dpp(0, (X), (CTRL), 0xF, 0xF, true)
            float u[16];
#pragma unroll
            for (int e = 0; e < 16; ++e) { auto rr = __builtin_amdgcn_permlane32_swap(__float_as_uint(lgA[e >> 1][e & 1]), __float_as_uint(lgB[e >> 1][e & 1]), false, false); u[e] = __uint_as_float(rr[0]) + __uint_as_float(rr[1]); }
            float w[8];
#pragma unroll
            for (int e = 0; e < 8; ++e) { auto rr = __builtin_amdgcn_permlane16_swap(__float_as_uint(u[e]), __float_as_uint(u[e + 8]), false, false); w[e] = __uint_as_float(rr[0]) + __uint_as_float(rr[1]); }
            float x[4];
#pragma unroll
            for (int i = 0; i < 4; ++i) { const float keep = hi8 ? w[i + 4] : w[i], send = hi8 ? w[i] : w[i + 4]; x[i] = keep + LN1_DPPF(0x128, send); }
            float y[2];
#pragma unroll
            for (int i = 0; i < 2; ++i) { const float keep = b2 ? x[i + 2] : x[i], send = b2 ? x[i] : x[i + 2]; y[i] = keep + LN1_DPPF(0x141, send); }
            float z = (b1 ? y[1] : y[0]) + LN1_DPPF(0x4E, (b1 ? y[0] : y[1]));
            z += LN1_DPPF(0xB1, z);
            const float sg = __builtin_amdgcn_rcpf(1.0f + __builtin_amdgcn_exp2f(-1.4426950408889634f * z)), bs = sg + rbv;
#define LN1_ARGSTEP(CTRL, M, V, I) do { const float om_ = LN1_DPPF(CTRL, M), ov_ = LN1_DPPF(CTRL, V); const int oi_ = LN1_DPPI(CTRL, I); const bool tk_ = (om_ > M) || (om_ == M && oi_ < I); \
                if (tk_) { M = om_; V = ov_; I = oi_; } } while (0)
            float m0 = bs, v0 = sg; int i0 = ex;
            LN1_ARGSTEP(0x4E, m0, v0, i0); LN1_ARGSTEP(0x141, m0, v0, i0);
            float m1 = (ex == i0) ? -INFINITY : bs, v1 = sg; int i1 = ex;
            LN1_ARGSTEP(0x4E, m1, v1, i1); LN1_ARGSTEP(0x141, m1, v1, i1);
            float bestg = m0 + m1, s0 = v0, s1 = v1; int epk = i0 | (i1 << 8);
            { const float og = LN1_DPPF(0x128, bestg), o0 = LN1_DPPF(0x128, s0), o1 = LN1_DPPF(0x128, s1); const int oe = LN1_DPPI(0x128, epk);
              const bool take = (og > bestg) || (og == bestg && hi8);
              if (take) { bestg = og; s0 = o0; s1 = o1; epk = oe; } }
            { auto x0_ = __builtin_amdgcn_permlane16_swap(__float_as_uint(bestg), __float_as_uint(bestg), false, false); auto x1_ = __builtin_amdgcn_permlane16_swap(__float_as_uint(s0), __float_as_uint(s0), false, false);
              auto x2_ = __builtin_amdgcn_permlane16_swap(__float_as_uint(s1), __float_as_uint(s1), false, false); auto x3_ = __builtin_amdgcn_permlane16_swap((unsigned)epk, (unsigned)epk, false, false);
              const float og = __uint_as_float(oddrow ? x0_[0] : x0_[1]), o0 = __uint_as_float(oddrow ? x1_[0] : x1_[1]), o1 = __uint_as_float(oddrow ? x2_[0] : x2_[1]); const int oe = (int)(oddrow ? x3_[0] : x3_[1]);
              const bool take = (og > bestg) || (og == bestg && oddrow);
              if (take) { bestg = og; s0 = o0; s1 = o1; epk = oe; } }
#undef LN1_ARGSTEP
#undef LN1_DPPF
#undef LN1_DPPI
            const int e0 = epk & 255, e1 = (epk >> 8) & 255;
            if ((F.lane & 31) == 0) { const int row = row0 + (F.lane >> 5); const float inv = __builtin_amdgcn_rcpf(s0 + s1); toke[row] = e0 | (e1 << 8); tokw[row * 2] = s0 * inv; tokw[row * 2 + 1] = s1 * inv;
                __hip_atomic_fetch_add((LAS unsigned*)(F.MISC + 16 + e0), 1u, __ATOMIC_RELAXED, __HIP_MEMORY_SCOPE_WORKGROUP); __hip_atomic_fetch_add((LAS unsigned*)(F.MISC + 16 + e1), 1u, __ATOMIC_RELAXED, __HIP_MEMORY_SCOPE_WORKGROUP); }
        }
    }
#undef LN1_LDX
    __syncthreads();
    if (F.tid < 16) bcnt[F.vcu * 16 + F.tid] = (int)F.MISC[16 + F.tid];
}

__device__ __forceinline__ void ph_dispatch(Frame F, int Mr) {
    { int t_ = threadIdx.x; asm volatile("" : "+v"(t_)); F.tid = t_; F.lane = t_ & 63; fresh_in(F); }
    const int* bcnt = (const int*)(F.ws + WS_BCNT); const int* toke = (const int*)(F.ws + WS_TOKE); int* tokp = (int*)(F.ws + WS_TOKP); int* meta = (int*)(F.ws + WS_META);
    const bf16* H2 = (const bf16*)(F.ws + WS_HL); bf16* XG = (bf16*)(F.ws + WS_XG);
    LAS int* ip = (LAS int*)F.lds;
    const int per = (F.G + 31) / 32;
    { const int e = F.tid & 15, grp = F.tid >> 4; int sa = 0, sb = 0;
      for (int k = 0; k < per; ++k) { const int blk = grp * per + k; if (blk < F.G) { const int cnt = bcnt[blk * 16 + e]; sa += cnt; if (blk < F.vcu) sb += cnt; } }
      ip[grp * 16 + e] = sa; ip[512 + grp * 16 + e] = sb; }
    __syncthreads();
    if (F.tid < 16) { int sa = 0, sb = 0;
        for (int g = 0; g < 32; ++g) { sa += ip[g * 16 + F.tid]; sb += ip[512 + g * 16 + F.tid]; }
        ip[1024 + F.tid] = sa; ip[1040 + F.tid] = sb; }
    __syncthreads();
    if (F.tid == 0) { int acc = 0;
        for (int e = 0; e < 16; ++e) { ip[1056 + e] = acc; acc += ((ip[1024 + e] + 255) >> 8) << 8; }
        ip[1056 + 16] = acc; }
    __syncthreads();
    if (F.vcu == 0 && F.tid < 17) meta[F.tid] = ip[1056 + F.tid] >> 8;
    const int n0 = F.vcu * NWAVES * F.rpw, n1 = min(n0 + NWAVES * F.rpw, Mr);
    int* rowl = (int*)(F.ws + WS_ROWL);
    if (F.wave == 0) {
        int run[16];
#pragma unroll
        for (int e = 0; e < 16; ++e) run[e] = ip[1056 + e] + ip[1040 + e];
        for (int t0 = n0; t0 < n1; t0 += 64) {
            const int tok = t0 + F.lane; const bool valid = tok < n1; const int ee = valid ? toke[tok] : 0xffff; const int e0 = ee & 255, e1 = (ee >> 8) & 255;
            int p0 = 0, p1 = 0; const unsigned long long lt = (1ull << F.lane) - 1ull;
#pragma unroll
            for (int e = 0; e < 16; ++e) { const unsigned long long m0 = __ballot(valid && e0 == e), m1 = __ballot(valid && e1 == e);
                if (e0 == e) p0 = run[e] + __popcll(m0 & lt);
                if (e1 == e) p1 = run[e] + __popcll(m0) + __popcll(m1 & lt);
                run[e] += __popcll(m0) + __popcll(m1); }
            if (valid) { tokp[tok * 2] = p0; tokp[tok * 2 + 1] = p1; rowl[p0] = tok; rowl[p1] = tok; }
        }
    }
    __syncthreads();
    {
        const int e = F.vcu & 15, part = F.vcu >> 4, nparts = (F.G + 15) >> 4;
        const int pr0 = ip[1056 + e] + ip[1024 + e], pr1 = ip[1056 + e + 1];
        int stride = nparts * NWAVES * 64; asm volatile("" : "+s"(stride));
        for (int p = pr0 + part * (NWAVES * 64) + F.tid; p < pr1; p += stride) rowl[p] = 0;
    }
}

__device__ __forceinline__ void ph_ln2(Frame F, int li, int Mr) {
    { int t_ = threadIdx.x; asm volatile("" : "+v"(t_)); F.tid = t_; F.lane = t_ & 63; fresh_in(F); }
    const float* mod = (const float*)(F.ws + WS_MOD);
    const bf16* Y = (const bf16*)(F.ws + WS_XG); bf16* HL = (bf16*)(F.ws + WS_HL);
    const float* tokw = (const float*)(F.ws + WS_TOKW); const int* tokp = (const int*)(F.ws + WS_TOKP);
    bf16* xb = (bf16*)(F.ws + WS_XB); static_assert(WS_XC == WS_XB + (size_t)LROWS * DM * 2, "context rows follow the latent rows");
    f32x4 lg[4], lb[4]; ld_f32(F.in[15] + li * DM, F.lane, lg); ld_f32(F.in[16] + li * DM, F.lane, lb);
    const int r0 = F.gw * F.rpw, r1 = min(r0 + F.rpw, Mr);
    const bool last = li == DEPTH - 1;
    int bcur = -1; f32x4 g2[4], sc1[4], sh1[4]; u32x2 nv[2][4], ny0[2][4], ny1[2][4];
#define LN2_LDX(S, RN) do { const int rn_ = (RN); const int q0_ = tokp[rn_ * 2], q1_ = tokp[rn_ * 2 + 1]; const bf16* xs_ = xb + (size_t)rn_ * DM; \
        _Pragma("unroll") for (int j = 0; j < 4; ++j) nv[S][j] = ((const GAS u32x2*)xs_)[64 * j + F.lane]; \
        _Pragma("unroll") for (int j = 0; j < 4; ++j) { ny0[S][j] = ((const GAS u32x2*)(Y + (size_t)q0_ * DM))[64 * j + F.lane]; ny1[S][j] = ((const GAS u32x2*)(Y + (size_t)q1_ * DM))[64 * j + F.lane]; } } while (0)
    if (r0 < r1) LN2_LDX(0, r0);
    if (r0 + 1 < r1) LN2_LDX(1, r0 + 1);
    for (int rw = r0; rw < r1; rw += 2) {
#pragma unroll
        for (int s = 0; s < 2; ++s) { const int row = rw + s; if (row < r1) {
            const int b = row < LROWS ? row >> 11 : 16;
            if (b != bcur) { bcur = b; const float* mb = mod + ((size_t)li * 17 + b) * 6144; ld_f32(mb + 5120, F.lane, g2);
                if (!last) { const float* mn = mod + ((size_t)(li + 1) * 17 + b) * 6144; ld_f32(mn, F.lane, sh1); ld_f32(mn + 1024, F.lane, sc1);
#pragma unroll
                    for (int j = 0; j < 4; ++j) sc1[j] = sc1[j] + 1.0f; } }
            bf16* xp = xb + (size_t)row * DM;
            const float w0 = tokw[row * 2], w1 = tokw[row * 2 + 1];
            f32x4 v[4];
#pragma unroll
            for (int j = 0; j < 4; ++j) { const f32x4 y0 = (f32x4){bflo(ny0[s][j].x), bfhi(ny0[s][j].x), bflo(ny0[s][j].y), bfhi(ny0[s][j].y)}, y1 = (f32x4){bflo(ny1[s][j].x), bfhi(ny1[s][j].x), bflo(ny1[s][j].y), bfhi(ny1[s][j].y)};
                v[j] = (f32x4){bflo(nv[s][j].x), bfhi(nv[s][j].x), bflo(nv[s][j].y), bfhi(nv[s][j].y)} * DN_ALPHA + g2[j] * (y0 * w0 + y1 * w1); }
            if (row + 2 < r1) LN2_LDX(s, row + 2);
            ln_core(v);
#pragma unroll
            for (int j = 0; j < 4; ++j) v[j] = v[j] * lg[j] + lb[j];
            if (last) st_f32(F.out + (size_t)row * DM, F.lane, v); else st_bf16(xp, F.lane, v);
            if (!last) {
#pragma unroll
                for (int j = 0; j < 4; ++j) v[j] = v[j] * sc1[j] + sh1[j];
                st_bf16(HL + (size_t)row * DM, F.lane, v);
            }
        } }
    }
#undef LN2_LDX
}

__global__ void __launch_bounds__(NWAVES * 64, 2) fwd(Args args) {
    extern __shared__ __attribute__((aligned(16))) unsigned char lds[];
    Frame F;
    F.lds = (LAS unsigned char*)lds; F.MISC = (volatile LAS unsigned*)(F.lds + MISC_OFF);
    F.tid = 0; F.lane = 0; F.wave = __builtin_amdgcn_readfirstlane((int)threadIdx.x >> 6);
    F.G = gridDim.x; { const int bx = blockIdx.x; F.vcu = (F.G % 8 == 0) ? (bx % 8) * (F.G / 8) + bx / 8 : bx; }
    F.gw = F.vcu * NWAVES + F.wave; F.NGW = F.G * NWAVES; F.rpw = (MROWS + F.NGW - 1) / F.NGW;
    fresh_in(F); F.out = args.out; F.ws = args.ws;
    for (int u = threadIdx.x; u < (LDS_BYTES - MISC_OFF) / 4; u += NWAVES * 64) F.MISC[u] = 0u;
    __syncthreads();
    XcdBarrier bar; bar.bar = (unsigned*)(args.ws + WS_CTL) + CW_BAR; bar.x = 0; bar.st = nullptr;
    if (!MK_PER_PHASE) bar = xcd_barrier_post((unsigned*)(args.ws + WS_CTL) + CW_BAR, F.MISC);
    const int lo = args.ph_lo, hi = args.ph_hi;
#ifndef PHMASK
#define PHMASK 0xFFFF
#endif
#define PE(n) (((PHMASK) >> (n)) & 1)
#define IN(k) (lo <= (k) && (k) < hi)
#define SEAM(k) do { if (!MK_PER_PHASE && IN(k) && IN((k) + 1)) xcd_barrier(bar); } while (0)

    if (PE(0) && IN(0)) { ph_prologue(F); SEAM(0); }
    if (PE(1) && IN(1)) { ph_hl0(F); SEAM(1); }

    bf16* HL = (bf16*)(args.ws + WS_HL); bf16* QB = (bf16*)(args.ws + WS_Q); bf16* KB = (bf16*)(args.ws + WS_K); bf16* VB = (bf16*)(args.ws + WS_V);
    bf16* AL = (bf16*)(args.ws + WS_AL); bf16* XG = (bf16*)(args.ws + WS_XG);
    const float* rope = (const float*)(args.ws + WS_ROPE);

    for (int li = 0; li < DEPTH; ++li) {
        const int pb = 2 + 8 * li; const bool typeB = (li & 1) != 0, last = li == DEPTH - 1; const int j = li >> 1;
        const int Mr = last ? LROWS : MROWS;
        if (PE(2) && IN(pb + 0)) {
            const bf16* W = typeB ? (const bf16*)(args.ws + WS_WQKVB) + (size_t)j * 3072 * 1024 : (const bf16*)(args.ws + WS_WQKVA) + (size_t)j * 1536 * 1024;
            const int N = typeB ? 3072 : 1536;
            pg8::Gemm g{HL, W, MROWS, N, DM, nullptr, nullptr}; pg8::StaticOrder S; S.init(MROWS, N, F.G, (int)blockIdx.x);
            pg8::EpiQKV E{QB, KB, VB, typeB ? 1024 : 256, typeB ? 4 : 1, rope, QSCALE};
            pg8::gemm_phase<pg8::EpiQKV, pg8::StaticOrder, true, true>(F.lds, g, S, E);
            if (li == 0) {
                const int nu = (MROWS / 256) * (N / 256), c = (int)blockIdx.x, busy = nu % F.G;
                if (busy > 0) { if (c >= busy) convert_experts(F, 0, (c - busy) * NWAVES + F.wave, (F.G - busy) * NWAVES); }
                else convert_experts(F, 0, F.gw, F.NGW);
            }
            SEAM(pb + 0);
        }
        if (IN(pb + 1)) {
            fresh_in(F);
            if (PE(3) && !typeB) {
                const int U = last ? 2048 : 2304;
                att::phase_A((LAS char*)F.lds, QB, KB, VB, QB, F.in[8] + j * 16, F.vcu, F.G, U);
            } else if (PE(4) && typeB) {
                const float lam_init = 0.8f - 0.6f * expf(-0.3f * (float)li);
                const float* lp = F.in[11] + j * 256;
                int ln_ = threadIdx.x; asm volatile("" : "+v"(ln_)); ln_ &= 63;
                const float d1 = wave_sum(lp[ln_] * lp[64 + ln_]), d2 = wave_sum(lp[128 + ln_] * lp[192 + ln_]);
                const float lam = expf(d1) - expf(d2) + lam_init;
                const int U = last ? 2048 : 2304;
                att::phase_B((LAS char*)F.lds, QB, KB, VB, QB, lam, 1.0f - lam_init, F.in[12] + j * 128, F.vcu, F.G, U);
            }
            SEAM(pb + 1);
        }
        if (PE(5) && IN(pb + 2)) {
            const bf16* W = typeB ? (const bf16*)(args.ws + WS_WOB) + (size_t)j * 1024 * 1024 : (const bf16*)(args.ws + WS_WOA) + (size_t)j * 1024 * 1024;
            pg8::Gemm g{QB, W, Mr, DM, DM, nullptr, nullptr}; pg8::StaticOrder S; S.init(Mr, DM, F.G, (int)blockIdx.x);
            pg8::EpiStore E{AL, DM};
            pg8::gemm_phase<pg8::EpiStore, pg8::StaticOrder, true, true>(F.lds, g, S, E);
            {
                const int nu = (Mr / 256) * 4, c = (int)blockIdx.x, busy = nu - 2 * F.G;
                if (!last && busy > 0 && busy < F.G) { if (c >= busy) convert_experts(F, li + 1, (c - busy) * NWAVES + F.wave, (F.G - busy) * NWAVES); }
                else if (!last) convert_experts(F, li + 1, F.gw, F.NGW);
            }
            SEAM(pb + 2);
        }
        if (PE(6) && IN(pb + 3)) { ph_ln1(F, li, Mr); SEAM(pb + 3); }
        if (PE(7) && IN(pb + 4)) { ph_dispatch(F, Mr); SEAM(pb + 4); }
        if (PE(8) && IN(pb + 5)) {
            const int* meta = (const int*)(args.ws + WS_META);
            { int t_ = threadIdx.x; asm volatile("" : "+v"(t_)); if (t_ < 17) F.MISC[32 + t_] = (unsigned)meta[t_]; }
            __syncthreads();
            pg8::Gemm g{HL, (const bf16*)(args.ws + WS_WGU) + (size_t)li * 16 * 1024 * 1024, 0, 1024, DM, (const int*)(args.ws + WS_ROWL), (LAS int*)(F.lds + ROWTAB_OFF)};
            pg8::GroupedOrder S; S.init((const LAS int*)(F.MISC + 32), F.G, (int)blockIdx.x);
            pg8::EpiGateUp E{AL};
            pg8::gemm_phase<pg8::EpiGateUp, pg8::GroupedOrder, true, true, true>(F.lds, g, S, E);
            SEAM(pb + 5);
        }
        if (PE(9) && IN(pb + 6)) {
            const int* meta = (const int*)(args.ws + WS_META);
            { int t_ = threadIdx.x; asm volatile("" : "+v"(t_)); if (t_ < 17) F.MISC[32 + t_] = (unsigned)meta[t_]; }
            __syncthreads();
            pg8::Gemm g{AL, (const bf16*)(args.ws + WS_WDN) + (size_t)li * 16 * 1024 * 512, 0, 1024, 512, nullptr, nullptr};
            pg8::GroupedOrder S; S.init((const LAS int*)(F.MISC + 32), F.G, (int)blockIdx.x);
            pg8::EpiStore E{XG, DM};
            pg8::gemm_phase<pg8::EpiStore, pg8::GroupedOrder, true, true>(F.lds, g, S, E);
            SEAM(pb + 6);
        }
        if (PE(10) && IN(pb + 7)) { ph_ln2(F, li, Mr); SEAM(pb + 7); }
    }
#undef IN
#undef SEAM
}

extern "C" void kernel_launch(void* const* d_in, const int* in_sizes, int n_in, void* d_out, int out_size, void* d_ws, size_t ws_size, hipStream_t stream) {
    static int grid = 0;
    if (grid == 0) {
        if (n_in != 22 || out_size != LROWS * DM || ws_size < WS_END) { fprintf(stderr, "kernel_launch: unexpected shapes (n_in %d, out %d, ws %zu < %zu); nothing launched\n", n_in, out_size, ws_size, (size_t)WS_END); grid = -1; return; }
        int dev = 0, cus = 0, per_cu = 0;
        if (hipGetDevice(&dev) != hipSuccess || hipDeviceGetAttribute(&cus, hipDeviceAttributeMultiprocessorCount, dev) != hipSuccess) { grid = -1; return; }
        if (hipFuncSetAttribute((const void*)fwd, hipFuncAttributeMaxDynamicSharedMemorySize, LDS_BYTES) != hipSuccess) { fprintf(stderr, "kernel_launch: hipFuncSetAttribute failed\n"); grid = -1; return; }
        if (hipOccupancyMaxActiveBlocksPerMultiprocessor(&per_cu, (const void*)fwd, NWAVES * 64, LDS_BYTES) != hipSuccess || per_cu < 1) { fprintf(stderr, "kernel_launch: occupancy query reports %d\n", per_cu); }
        (void)hipGetLastError();
        grid = cus;
    }
    if (grid < 0) return;
    (void)hipMemsetAsync((char*)d_ws + WS_CTL, 0, CTL_ZERO_BYTES, stream);
    Args a{};
    for (int i = 0; i < 22; ++i) a.in[i] = (const float*)d_in[i];
    a.out = (float*)d_out; a.ws = (unsigned char*)d_ws;
#if MK_PER_PHASE
    for (int p = 0; p < NPHASE; ++p) { a.ph_lo = p; a.ph_hi = p + 1; hipLaunchKernelGGL(fwd, dim3(grid), dim3(NWAVES * 64), LDS_BYTES, stream, a); }
#else
    a.ph_lo = 0; a.ph_hi = NPHASE; hipLaunchKernelGGL(fwd, dim3(grid), dim3(NWAVES * 64), LDS_BYTES, stream, a);
#endif
}
```
